# Optimizing an MI355X kernel written in HIP

```python
import jax, jax.numpy as jnp
from jax import lax
import numpy as np

D_MODEL = 1024
BATCH = 4
SEQ = 8192
DEPTH = 1

N_META = 16
CHUNK = 128
HGRN_HEADS = 4
HGRN_HEAD_DIM = 128
HGRN_WIDTH = HGRN_HEADS * HGRN_HEAD_DIM
CONV_GROUPS = 4
CONV_WIDTH_CH = 512
CONV_K = 3
MIX_WIDTH = HGRN_WIDTH + CONV_WIDTH_CH
IN_PROJ_WIDTH = 4 * HGRN_WIDTH + 3 * CONV_WIDTH_CH
N_EXPERTS = 64
TOP_K = 8
EXPERT_FF = 256
SHARED_FF = 256
ROUTED_SCALE = 2.5
EXPERT_BLOCK = 128
EPS = 1e-6

kernel_name = 'hymba_hgrn2_shortconv_moe'


def rmsnorm(x, g):
    xf = x.astype(jnp.float32)
    y = xf * lax.rsqrt(jnp.mean(xf * xf, axis=-1, keepdims=True) + EPS)
    return (y * g.astype(jnp.float32)).astype(x.dtype)


def group_rmsnorm(x, g, n_groups):
    shp = x.shape
    xf = x.astype(jnp.float32).reshape(shp[:-1] + (n_groups, shp[-1] // n_groups))
    y = xf * lax.rsqrt(jnp.mean(xf * xf, axis=-1, keepdims=True) + EPS)
    return (y.reshape(shp) * g.astype(jnp.float32)).astype(x.dtype)


def hgrn2_mixer(q, f_pre, i_val, g_out, lb, norm_g):
    bsz, t_len, _ = q.shape
    lb = lb.astype(jnp.float32)
    z = f_pre.astype(jnp.float32)
    log_f = jnp.log(lb + (1.0 - lb) * jax.nn.sigmoid(z))
    k = (1.0 - lb) * jax.nn.sigmoid(-z)
    pad = CHUNK - N_META

    def to_chunks(a):
        a = jnp.pad(a.astype(jnp.float32), ((0, 0), (pad, 0), (0, 0)))
        n = a.shape[1] // CHUNK
        return a.reshape(bsz, n, CHUNK, HGRN_HEADS, HGRN_HEAD_DIM).transpose(1, 0, 3, 2, 4)

    qc, kc, vc, lfc = to_chunks(q), to_chunks(k), to_chunks(i_val), to_chunks(log_f)
    causal = jnp.tril(jnp.ones((CHUNK, CHUNK), dtype=bool))

    def step(state, inp):
        qb, kb, vb, lfb = inp
        b = jnp.cumsum(lfb, axis=2)
        diff = b[:, :, :, None, :] - b[:, :, None, :, :]
        decay = jnp.exp(jnp.where(causal[:, :, None], diff, -jnp.inf))
        scores = jnp.einsum('bhtd,bhsd,bhtsd->bhts', qb, kb, decay)
        o = (jnp.einsum('bhts,bhsv->bhtv', scores, vb)
             + jnp.einsum('bhtd,bhdv->bhtv', qb * jnp.exp(b), state))
        b_last = b[:, :, -1:, :]
        state = (jnp.exp(b_last[:, :, 0, :])[..., None] * state
                 + jnp.einsum('bhsd,bhsv->bhdv', kb * jnp.exp(b_last - b), vb))
        return state, o

    s0 = jnp.zeros((bsz, HGRN_HEADS, HGRN_HEAD_DIM, HGRN_HEAD_DIM), jnp.float32)
    _, o = lax.scan(step, s0, (qc, kc, vc, lfc))
    n = o.shape[0]
    o = o.transpose(1, 0, 3, 2, 4).reshape(bsz, n * CHUNK, HGRN_WIDTH)[:, pad:]
    o = group_rmsnorm(o, norm_g, HGRN_HEADS) * jax.nn.silu(g_out.astype(jnp.float32))
    return o.astype(q.dtype)


def short_conv_mixer(b_gate, c_gate, v, conv_w, norm_g):
    u = c_gate * v
    y = lax.conv_general_dilated(
        u, conv_w[:, None, :].astype(u.dtype), window_strides=(1,),
        padding=[(CONV_K - 1, 0)], dimension_numbers=('NWC', 'WIO', 'NWC'),
        feature_group_count=CONV_WIDTH_CH)
    return group_rmsnorm(b_gate * y, norm_g, CONV_GROUPS)


def swiglu(x, w_gate, w_up, w_down):
    return (jax.nn.silu(x @ w_gate) * (x @ w_up)) @ w_down


def moe_ffn(xn, w_router, router_bias, w_gate_e, w_up_e, w_down_e, w_gate_s, w_up_s, w_down_s):
    bsz, t_len, d = xn.shape
    xt = xn.reshape(-1, d)
    n_tok = xt.shape[0]
    scores = jax.nn.sigmoid((xt @ w_router).astype(jnp.float32))
    _, top_idx = lax.top_k(scores + router_bias.astype(jnp.float32), TOP_K)
    top_s = jnp.take_along_axis(scores, top_idx, axis=-1)
    gates = top_s / jnp.sum(top_s, axis=-1, keepdims=True) * ROUTED_SCALE

    m = n_tok * TOP_K
    flat_e = top_idx.reshape(-1)
    flat_tok = jnp.repeat(jnp.arange(n_tok, dtype=jnp.int32), TOP_K)
    flat_g = gates.reshape(-1)
    order = jnp.argsort(flat_e, stable=True)
    e_sorted, tok_sorted, g_sorted = flat_e[order], flat_tok[order], flat_g[order]
    counts = jnp.bincount(flat_e, length=N_EXPERTS)
    starts = jnp.cumsum(counts) - counts
    padded = (counts + EXPERT_BLOCK - 1) // EXPERT_BLOCK * EXPERT_BLOCK
    pad_ends = jnp.cumsum(padded)
    pad_starts = pad_ends - padded
    dest = pad_starts[e_sorted] + jnp.arange(m, dtype=jnp.int32) - starts[e_sorted]
    n_blocks = -(-m // EXPERT_BLOCK) + N_EXPERTS
    rows = n_blocks * EXPERT_BLOCK
    src_tok = jnp.zeros((rows,), jnp.int32).at[dest].set(tok_sorted)
    row_gate = jnp.zeros((rows,), jnp.float32).at[dest].set(g_sorted)
    block_expert = jnp.minimum(
        jnp.searchsorted(pad_ends, jnp.arange(n_blocks) * EXPERT_BLOCK, side='right'),
        N_EXPERTS - 1)

    def expert_block(args):
        tok_idx, g, e = args
        xb = xt[tok_idx]
        yb = swiglu(xb, w_gate_e[e], w_up_e[e], w_down_e[e])
        return yb * g[:, None].astype(yb.dtype)

    y_rows = lax.map(expert_block, (src_tok.reshape(n_blocks, EXPERT_BLOCK),
                                    row_gate.reshape(n_blocks, EXPERT_BLOCK),
                                    block_expert))
    routed = jnp.zeros_like(xt).at[src_tok].add(y_rows.reshape(rows, d))
    shared = swiglu(xt, w_gate_s, w_up_s, w_down_s)
    return (routed + shared).reshape(bsz, t_len, d)


def setup_inputs(seed: int = 0) -> dict:
    key = jax.random.key(seed)
    ks = jax.random.split(key, 20)
    nrm = jax.random.normal
    return {
        'x': nrm(ks[0], (BATCH, SEQ, D_MODEL), jnp.float32),
        'meta_tokens': nrm(ks[1], (N_META, D_MODEL), jnp.float32),
        'norm_mix_g': 1.0 + 0.02 * nrm(ks[2], (DEPTH, D_MODEL), jnp.float32),
        'w_in': nrm(ks[3], (DEPTH, D_MODEL, IN_PROJ_WIDTH), jnp.float32) * D_MODEL ** -0.5,
        'lb_table': 0.5 * nrm(ks[4], (DEPTH + 1, HGRN_WIDTH), jnp.float32),
        'hgrn_norm_g': 1.0 + 0.02 * nrm(ks[5], (DEPTH, HGRN_WIDTH), jnp.float32),
        'conv_w': nrm(ks[6], (DEPTH, CONV_K, CONV_WIDTH_CH), jnp.float32) * CONV_K ** -0.5,
        'conv_norm_g': 1.0 + 0.02 * nrm(ks[7], (DEPTH, CONV_WIDTH_CH), jnp.float32),
        'w_out': nrm(ks[8], (DEPTH, MIX_WIDTH, D_MODEL), jnp.float32) * MIX_WIDTH ** -0.5,
        'norm_ffn_g': 1.0 + 0.02 * nrm(ks[9], (DEPTH, D_MODEL), jnp.float32),
        'w_router': nrm(ks[10], (DEPTH, D_MODEL, N_EXPERTS), jnp.float32) * D_MODEL ** -0.5,
        'router_bias': 0.01 * nrm(ks[11], (DEPTH, N_EXPERTS), jnp.float32),
        'w_gate_e': nrm(ks[12], (DEPTH, N_EXPERTS, D_MODEL, EXPERT_FF), jnp.float32) * D_MODEL ** -0.5,
        'w_up_e': nrm(ks[13], (DEPTH, N_EXPERTS, D_MODEL, EXPERT_FF), jnp.float32) * D_MODEL ** -0.5,
        'w_down_e': nrm(ks[14], (DEPTH, N_EXPERTS, EXPERT_FF, D_MODEL), jnp.float32) * EXPERT_FF ** -0.5,
        'w_gate_s': nrm(ks[15], (DEPTH, D_MODEL, SHARED_FF), jnp.float32) * D_MODEL ** -0.5,
        'w_up_s': nrm(ks[16], (DEPTH, D_MODEL, SHARED_FF), jnp.float32) * D_MODEL ** -0.5,
        'w_down_s': nrm(ks[17], (DEPTH, SHARED_FF, D_MODEL), jnp.float32) * SHARED_FF ** -0.5,
        'norm_final_g': 1.0 + 0.02 * nrm(ks[18], (D_MODEL,), jnp.float32),
    }


def reference(x, meta_tokens, norm_mix_g, w_in, lb_table, hgrn_norm_g, conv_w, conv_norm_g,
              w_out, norm_ffn_g, w_router, router_bias, w_gate_e, w_up_e, w_down_e,
              w_gate_s, w_up_s, w_down_s, norm_final_g):
    bsz = x.shape[0]
    meta = jnp.broadcast_to(meta_tokens.astype(x.dtype)[None], (bsz, N_META, D_MODEL))
    h = jnp.concatenate([meta, x], axis=1)
    lower_bounds = jnp.cumsum(jax.nn.softmax(lb_table.astype(jnp.float32), axis=0), axis=0)
    split_at = np.cumsum([HGRN_WIDTH] * 4 + [CONV_WIDTH_CH] * 3)[:-1].tolist()
    for l in range(DEPTH):
        xn = rmsnorm(h, norm_mix_g[l])
        proj = xn @ w_in[l]
        q, f_pre, i_val, g_out, b_gate, c_gate, v = jnp.split(proj, split_at, axis=-1)
        y_hgrn = hgrn2_mixer(q, f_pre, i_val, g_out, lower_bounds[l], hgrn_norm_g[l])
        y_conv = short_conv_mixer(b_gate, c_gate, v, conv_w[l], conv_norm_g[l])
        h = h + jnp.concatenate([y_hgrn, y_conv], axis=-1) @ w_out[l]
        h = h + moe_ffn(rmsnorm(h, norm_ffn_g[l]), w_router[l], router_bias[l],
                        w_gate_e[l], w_up_e[l], w_down_e[l],
                        w_gate_s[l], w_up_s[l], w_down_s[l])
    return rmsnorm(h, norm_final_g)[:, N_META:]
```

```cpp
#include <hip/hip_runtime.h>
#include <cstdio>
#include <cstdint>

#define GAS __attribute__((address_space(1)))
#define LAS __attribute__((address_space(3)))
typedef unsigned short bf16;
typedef unsigned v4u __attribute__((ext_vector_type(4)));
typedef unsigned v2u __attribute__((ext_vector_type(2)));
typedef float f32x4 __attribute__((ext_vector_type(4)));
typedef float f32x2 __attribute__((ext_vector_type(2)));
typedef short bf16x8 __attribute__((ext_vector_type(8)));

#ifndef FAST_GEMM
#define FAST_GEMM 15
#endif
#ifndef REPEAT
#define REPEAT 0
#endif
#define REP(k) for (int _rep = 0; _rep < 1 + ((REPEAT >> (k)) & 1); ++_rep)
#ifndef P0_SPLIT
#define P0_SPLIT 12480
#endif
#ifndef GEMM_CUS_CFG
#define GEMM_CUS_CFG 224
#endif
#ifndef HGRN_SEG
#define HGRN_SEG 1
#endif
#ifndef FP8_E1
#define FP8_E1 1
#endif
#ifndef FP8_E2
#define FP8_E2 1
#endif
#ifndef E2_CUSTOM
#define E2_CUSTOM 0
#endif
#ifndef FAST_HGRN
#define FAST_HGRN 1
#endif

constexpr int D = 1024, NB = 4, SEQ = 8192, NMETA = 16, NTOK = NB * SEQ, MROWS = 33024, PW = 3584, HW = 512;
constexpr int NE = 64, TOPK = 8, FF = 256;
constexpr float EPS = 1e-6f, ROUTED_SCALE = 2.5f, YSCALE = 16.f, WQ_SCALE = 32.f, HQ_SCALE = 8.f, WDQ_SCALE = 16.f, F8MAX = 448.f;
constexpr int NWAVES = 8, NTHREADS = NWAVES * 64;
constexpr int LDS_BYTES = 147456;
constexpr int RING_BYTES = 131072, MISC_OFF = RING_BYTES + 320, TAB_OFF = RING_BYTES + 1024, IDX_OFF = RING_BYTES + 2048, UT_OFF = RING_BYTES + 13312;

constexpr size_t MiB = 1u << 20;
constexpr size_t WS_CTL = 0, CTL_ZERO_BYTES = 1 * MiB;
constexpr int CW_BAR = 4096;
constexpr int CW_CNT = 32768;
constexpr size_t WS_SUMSQ = 256 * 1024;
constexpr size_t WS_TOK = 1 * MiB;
constexpr size_t WS_SCL = 9 * MiB;
constexpr size_t WS_SLOT = 25 * MiB;
constexpr size_t WS_SCLS = 26 * MiB;
constexpr size_t WS_RINV = 26 * MiB + 256 * 1024;
constexpr size_t WS_LB = 26 * MiB + 512 * 1024;
constexpr size_t WS_WIN = 27 * MiB;
constexpr size_t WS_WOUT = 34 * MiB;
constexpr size_t WS_WR = 36 * MiB;
constexpr size_t WS_XN = 37 * MiB;
constexpr size_t WS_Y = 429 * MiB;
constexpr size_t WS_PROJ = 102 * MiB;
constexpr size_t WS_ORAW = 328 * MiB;
constexpr size_t WS_DS = 37 * MiB;
constexpr size_t WS_SS = 392 * MiB;
constexpr size_t WS_DD = 494 * MiB;
constexpr size_t WS_DSM = 495 * MiB;
constexpr size_t WS_H1Q = 102 * MiB;
constexpr size_t WS_H1 = 293 * MiB;
constexpr size_t WS_HID = 357 * MiB;
constexpr size_t WS_YR = 37 * MiB;
constexpr size_t WS_YS = 430 * MiB;
constexpr size_t WS_END = 502 * MiB;
constexpr size_t OUT_WGU = 0, OUT_WD = (size_t)65 * 512 * 1024 * 2;

__device__ __forceinline__ float bf2f(bf16 h) { return __builtin_bit_cast(float, (unsigned)h << 16); }
__device__ __forceinline__ float bflo(unsigned w) { return __builtin_bit_cast(float, w << 16); }
__device__ __forceinline__ float bfhi(unsigned w) { return __builtin_bit_cast(float, w & 0xffff0000u); }
typedef __bf16 bf16x2_t __attribute__((ext_vector_type(2)));
__device__ __forceinline__ unsigned pk2(float lo, float hi) { const f32x2 v = {lo, hi}; return __builtin_bit_cast(unsigned, __builtin_convertvector(v, bf16x2_t)); }
__device__ __forceinline__ unsigned f2bf(float f) { return pk2(f, 0.f) & 0xffffu; }
__device__ __forceinline__ float fexp_(float x) { return __builtin_amdgcn_exp2f(x * 1.4426950408889634f); }
__device__ __forceinline__ float flog_(float x) { return __builtin_amdgcn_logf(x) * 0.6931471805599453f; }
__device__ __forceinline__ float rcpf_(float x) { return __builtin_amdgcn_rcpf(x); }
__device__ __forceinline__ float rsqf_(float x) { return __builtin_amdgcn_rsqf(x); }
__device__ __forceinline__ float sigmoidf_(float x) { return rcpf_(1.f + fexp_(-x)); }
__device__ __forceinline__ float siluf_(float x) { return x * rcpf_(1.f + fexp_(-x)); }
#define LDS_WAIT() asm volatile("s_waitcnt lgkmcnt(0)" ::: "memory")
#define WG_BARRIER() do { asm volatile("s_waitcnt lgkmcnt(0)" ::: "memory"); __builtin_amdgcn_s_barrier(); asm volatile("" ::: "memory"); } while (0)
#define VM_WAIT() asm volatile("s_waitcnt vmcnt(0)" ::: "memory")

#define XB_TMO      128
#define XB_XCNT(j)  (256  + 64 * (j))
#define XB_XSUB(j)  (1280 + 64 * (j))
#define XB_XGEN(j)  (2304 + 64 * (j))
#define XB_TOP      3328
#define XB_TOPGEN   3392
#define XCD_BAR_WORDS 3456
#define XB_SPIN_CAP (1u << 18)
__device__ __forceinline__ unsigned xb_ld(unsigned* p)              { return __hip_atomic_load(p, __ATOMIC_RELAXED, __HIP_MEMORY_SCOPE_AGENT); }
__device__ __forceinline__ unsigned xb_add(unsigned* p, unsigned v) { return __hip_atomic_fetch_add(p, v, __ATOMIC_RELAXED, __HIP_MEMORY_SCOPE_AGENT); }
__device__ __forceinline__ unsigned xb_xcc_id() { return (unsigned)__builtin_amdgcn_s_getreg((3 << 11) | 20) & 0xFu; }
#define XB_SPIN(cond, bar) do { unsigned _sp = 0; while (cond) { __builtin_amdgcn_s_sleep(1); \
    if ((++_sp & 255u) == 0u) { if (xb_ld(&(bar)[XB_TMO])) break; if (_sp > XB_SPIN_CAP) { atomicAdd(&(bar)[XB_TMO], 1u); break; } } } } while (0)
struct XcdBarrier { unsigned* bar; unsigned x; volatile LAS unsigned* st; };
__device__ __forceinline__ XcdBarrier xcd_barrier_post(unsigned* bar, volatile LAS unsigned* st) {
    XcdBarrier b; b.bar = bar; b.x = xb_xcc_id(); b.st = st;
    if (threadIdx.x == 0) (void)xb_add(&bar[XB_XCNT(b.x)], 1u);
    return b;
}
__device__ __forceinline__ void xcd_barrier_complete(unsigned* bar, unsigned x, unsigned& nloc, unsigned& nx) {
    const unsigned G = gridDim.x * gridDim.y * gridDim.z;
    unsigned sum, cnt, mine, sp = 0u;
    for (;;) {
        sum = 0u; cnt = 0u; mine = 0u;
#pragma unroll
        for (unsigned j = 0; j < 16; ++j) { const unsigned c = xb_ld(&bar[XB_XCNT(j)]); sum += c; cnt += (c > 0u) ? 1u : 0u; mine = (j == x) ? c : mine; }
        if (sum == G) break;
        __builtin_amdgcn_s_sleep(1);
        if ((++sp & 255u) == 0u) { if (xb_ld(&bar[XB_TMO])) break; if (sp > XB_SPIN_CAP) { atomicAdd(&bar[XB_TMO], 1u); break; } }
    }
    nloc = mine > 0u ? mine : 1u; nx = cnt > 0u ? cnt : 1u;
}
__device__ __forceinline__ void xcd_barrier(const XcdBarrier& b) {
    asm volatile("s_waitcnt vmcnt(0)" ::: "memory");
    __syncthreads();
    if (threadIdx.x == 0) {
        unsigned* bar = b.bar;
        __builtin_amdgcn_s_waitcnt(0);
        unsigned nloc = b.st[0], nx = b.st[1];
        if (nloc == 0u) { xcd_barrier_complete(bar, b.x, nloc, nx); b.st[0] = nloc; b.st[1] = nx; }
        const unsigned old = xb_add(&bar[XB_XSUB(b.x)], 1u);
        const unsigned gen = old / nloc;
        if (old + 1u == (gen + 1u) * nloc) {
            __builtin_amdgcn_fence(__ATOMIC_RELEASE, "agent");
            asm volatile("s_waitcnt vmcnt(0)" ::: "memory");
            const unsigned og = xb_add(&bar[XB_TOP], 1u);
            const unsigned tg = og / nx;
            if (og + 1u == (tg + 1u) * nx) xb_add(&bar[XB_TOPGEN], 1u);
            else XB_SPIN(xb_ld(&bar[XB_TOPGEN]) == tg, bar);
            __builtin_amdgcn_fence(__ATOMIC_ACQUIRE, "agent");
            xb_add(&bar[XB_XGEN(b.x)], 1u);
            asm volatile("s_waitcnt vmcnt(0)" ::: "memory");
        } else {
            XB_SPIN(xb_ld(&bar[XB_XGEN(b.x)]) == gen, bar);
            __builtin_amdgcn_fence(__ATOMIC_ACQUIRE, "agent");
            asm volatile("s_waitcnt vmcnt(0)" ::: "memory");
        }
    }
    __syncthreads();
}

struct Args { const float* in[19]; float* out; unsigned char* ws; int ph_lo, ph_hi; };
struct Frame {
    LAS unsigned char* lds;
    int tid, lane, wave, G, vcu;
    const float* in[19]; float* out; unsigned char* ws;
};
__device__ __forceinline__ float wave_sum(float v) {
#pragma unroll
    for (int o = 1; o < 64; o <<= 1) v += __shfl_xor(v, o);
    return v;
}

constexpr bool ProbE1Q = (FP8_E1 != 0) && ((FAST_GEMM & 4) != 0), ProbE2Q = (FP8_E2 != 0) && ((FAST_GEMM & 8) != 0) && ((FAST_GEMM & 4) != 0);
struct P0Item { const float* W; bf16* WT; const float* kscale; int K, N, k0, n0, orow0, q8; float qs; };
__device__ __forceinline__ void p0_item(Frame& F, int it, P0Item& I) {
    bf16* WinT = (bf16*)(F.ws + WS_WIN); bf16* WoutT = (bf16*)(F.ws + WS_WOUT); bf16* WrT = (bf16*)(F.ws + WS_WR);
    bf16* WGU = (bf16*)((unsigned char*)F.out + OUT_WGU); bf16* WD = (bf16*)((unsigned char*)F.out + OUT_WD);
    constexpr int I_IN = 16 * 112, I_OUT = 16 * 32, I_R = 16 * 2, I_E = 384;
    int r = it;
    if (r < I_IN) { I.W = F.in[3]; I.q8 = 0; I.WT = WinT; I.kscale = F.in[2]; I.K = D; I.N = PW; I.k0 = 64 * (r / 112); I.n0 = 32 * (r % 112); I.orow0 = I.n0; return; } r -= I_IN;
    if (r < I_OUT) { I.W = F.in[8]; I.q8 = 0; I.WT = WoutT; I.kscale = nullptr; I.K = D; I.N = D; I.k0 = 64 * (r / 32); I.n0 = 32 * (r % 32); I.orow0 = I.n0; return; } r -= I_OUT;
    if (r < I_R) { I.W = F.in[10]; I.q8 = 0; I.WT = WrT; I.kscale = F.in[9]; I.K = D; I.N = NE; I.k0 = 64 * (r / 2); I.n0 = 32 * (r % 2); I.orow0 = I.n0; return; } r -= I_R;
    const int e = r / I_E, q = r % I_E, kind = q / 128, idx = q % 128;
    if (kind < 2) {
        I.W = (e < NE) ? (kind == 0 ? F.in[12] : F.in[13]) + (size_t)e * D * FF : (kind == 0 ? F.in[15] : F.in[16]);
        I.q8 = ProbE1Q ? 1 : 0; I.qs = WQ_SCALE; I.WT = ProbE1Q ? (bf16*)((unsigned char*)WGU + (size_t)e * 512 * D) : WGU + (size_t)e * 512 * D; I.kscale = F.in[9]; I.K = D; I.N = FF; I.k0 = 64 * (idx / 8); I.n0 = 32 * (idx % 8); I.orow0 = (I.n0 / 128) * 256 + (kind == 1 ? 128 : 0) + (I.n0 % 128);
    } else {
        I.W = (e < NE) ? F.in[14] + (size_t)e * FF * D : F.in[17];
        I.q8 = ProbE2Q ? 1 : 0; I.qs = WDQ_SCALE; I.WT = ProbE2Q ? (bf16*)((unsigned char*)WD + (size_t)e * D * FF) : WD + (size_t)e * D * FF; I.kscale = nullptr; I.K = FF; I.N = D; I.k0 = 64 * (idx / 32); I.n0 = 32 * (idx % 32); I.orow0 = I.n0;
    }
}
__device__ __forceinline__ void p0_load(const P0Item& I, int lane, f32x4 (&v)[8]) {
#pragma unroll
    for (int i = 0; i < 8; ++i) { const int kk = 8 * i + (lane >> 3); v[i] = __builtin_nontemporal_load((const f32x4*)(I.W + (size_t)(I.k0 + kk) * I.N + I.n0 + 4 * (lane & 7))); }
}
__device__ __forceinline__ void p0_store(const P0Item& I, int lane, f32x4 (&v)[8], LAS float* scr) {
    if (I.kscale) {
#pragma unroll
        for (int i = 0; i < 8; ++i) v[i] *= I.kscale[I.k0 + 8 * i + (lane >> 3)];
    }
#pragma unroll
    for (int i = 0; i < 8; ++i) { LAS float* d = scr + (8 * i + (lane >> 3)) * 33 + 4 * (lane & 7); d[0] = v[i][0]; d[1] = v[i][1]; d[2] = v[i][2]; d[3] = v[i][3]; }
    LDS_WAIT(); asm volatile("" ::: "memory");
    if (I.q8) {
        const int c = lane & 3;
#pragma unroll
        for (int j = 0; j < 2; ++j) { const int n = (lane >> 2) + 16 * j; const LAS float* s = scr + (16 * c) * 33 + n; unsigned w[4];
#pragma unroll
            for (int q = 0; q < 4; ++q) { int t = __builtin_amdgcn_cvt_pk_fp8_f32(s[(4 * q) * 33] * I.qs, s[(4 * q + 1) * 33] * I.qs, 0, false); t = __builtin_amdgcn_cvt_pk_fp8_f32(s[(4 * q + 2) * 33] * I.qs, s[(4 * q + 3) * 33] * I.qs, t, true); w[q] = (unsigned)t; }
            __builtin_nontemporal_store((v4u){w[0], w[1], w[2], w[3]}, (v4u*)((unsigned char*)I.WT + (size_t)(I.orow0 + n) * I.K + I.k0 + 16 * c)); }
    } else {
    const int c = lane & 7;
#pragma unroll
    for (int j = 0; j < 4; ++j) { const int n = (lane >> 3) + 8 * j; const LAS float* s = scr + (8 * c) * 33 + n;
        v4u o; o.x = pk2(s[0 * 33], s[1 * 33]); o.y = pk2(s[2 * 33], s[3 * 33]); o.z = pk2(s[4 * 33], s[5 * 33]); o.w = pk2(s[6 * 33], s[7 * 33]);
        *(v4u*)(I.WT + (size_t)(I.orow0 + n) * I.K + I.k0 + 8 * c) = o; }
    }
    LDS_WAIT(); asm volatile("" ::: "memory");
}
__device__ __forceinline__ void p0_xn_row(Frame& F, int m, bf16* XN, int lane) {
    v2u* o8 = (v2u*)(XN + (size_t)m * D) + lane;
    if (m >= NTOK + NMETA) {
#pragma unroll
        for (int j = 0; j < 4; ++j) o8[64 * j] = (v2u){0u, 0u};
        return;
    }
    const float* xrow = (m < NTOK) ? F.in[0] + (size_t)m * D : F.in[1] + (size_t)(m - NTOK) * D;
    const f32x4* xr = (const f32x4*)xrow + lane;
    f32x4 v[4]; float s = 0.f;
#pragma unroll
    for (int j = 0; j < 4; ++j) { v[j] = __builtin_nontemporal_load(xr + 64 * j); s += (v[j].x * v[j].x + v[j].y * v[j].y) + (v[j].z * v[j].z + v[j].w * v[j].w); }
    const float ms = wave_sum(s) * (1.f / D) + EPS, rstd = rsqf_(ms);
    if (m < NTOK && lane == 0) ((float*)(F.ws + WS_RINV))[m] = ms * rstd;
#pragma unroll
    for (int j = 0; j < 4; ++j) o8[64 * j] = (v2u){pk2(v[j].x * rstd, v[j].y * rstd), pk2(v[j].z * rstd, v[j].w * rstd)};
}
constexpr int P0_NONEXPERT = 16 * 112 + 16 * 32 + 16 * 2, P0_NITEMS = P0_NONEXPERT + 65 * 384;
__device__ __forceinline__ void p0_convert(Frame& F, int lo, int hi, int gw, int NGW) {
    LAS float* scr = (LAS float*)(F.lds + F.wave * 16384); const int lane = F.lane;
    if (lo + gw >= hi) return;
    P0Item cur, nxt; f32x4 va[8], vb[8];
    p0_item(F, lo + gw, cur); p0_load(cur, lane, va);
    for (int it = lo + gw; it < hi; it += 2 * NGW) {
        const bool h1 = it + NGW < hi;
        if (h1) { p0_item(F, it + NGW, nxt); p0_load(nxt, lane, vb); }
        p0_store(cur, lane, va, scr);
        const bool h2 = it + 2 * NGW < hi;
        if (h2) { p0_item(F, it + 2 * NGW, cur); p0_load(cur, lane, va); }
        if (h1) p0_store(nxt, lane, vb, scr);
    }
}
__device__ __forceinline__ void meta_proj(Frame& F, int gw, int NGW) {
    const bf16* XN = (const bf16*)(F.ws + WS_XN); const bf16* W = (const bf16*)(F.ws + WS_WIN); bf16* PROJ = (bf16*)(F.ws + WS_PROJ);
    const int lane = F.lane, fr = lane & 15, fq = lane >> 4;
    for (int nt = gw; nt < PW / 16; nt += NGW) {
        f32x4 acc = {0.f, 0.f, 0.f, 0.f};
        const bf16* ap = XN + (size_t)(NTOK + fr) * D + 8 * fq; const bf16* bp = W + (size_t)(16 * nt + fr) * D + 8 * fq;
#pragma unroll 8
        for (int k0 = 0; k0 < D; k0 += 32) acc = __builtin_amdgcn_mfma_f32_16x16x32_bf16(*(const bf16x8*)(ap + k0), *(const bf16x8*)(bp + k0), acc, 0, 0, 0);
#pragma unroll
        for (int j = 0; j < 4; ++j) PROJ[(size_t)(NTOK + 4 * fq + j) * PW + 16 * nt + fr] = (bf16)f2bf(acc[j]);
    }
}
__device__ __forceinline__ void p0_prologue(Frame& F) {
    const int gw = F.vcu * NWAVES + F.wave, NGW = F.G * NWAVES, lane = F.lane;
    bf16* XN = (bf16*)(F.ws + WS_XN);
    for (int m = gw; m < MROWS; m += NGW) p0_xn_row(F, m, XN, lane);
    p0_convert(F, 0, (GEMM_CUS_CFG >= 256) ? P0_NITEMS : P0_NONEXPERT + P0_SPLIT, gw, NGW);
    if (blockIdx.x == 0) {
        float* LB = (float*)(F.ws + WS_LB);
        const float t0 = F.in[4][F.tid], t1 = F.in[4][HW + F.tid];
        LB[F.tid] = 1.f / (1.f + fexp_(t1 - t0));
    }
}

struct Unit { int pm, pn, e, rows; };
struct MoeTab { LAS int* cnt; LAS int* rowbase; LAS int* tb; };
__device__ __forceinline__ void moe_build_tab(Frame& F, MoeTab& T) {
    T.cnt = (LAS int*)(F.lds + TAB_OFF); T.rowbase = T.cnt + 64; T.tb = T.rowbase + 65;
    if (F.tid < NE) {
        const unsigned* counts = (const unsigned*)(F.ws + WS_CTL) + CW_CNT;
        const int c = (int)__hip_atomic_load(counts + F.tid, __ATOMIC_RELAXED, __HIP_MEMORY_SCOPE_AGENT), t = (c + 255) >> 8;
        int rb = c, tb = t;
#pragma unroll
        for (int o = 1; o < 64; o <<= 1) { const int a = __shfl_up(rb, o), b = __shfl_up(tb, o); if (F.lane >= o) { rb += a; tb += b; } }
        T.cnt[F.tid] = c; T.rowbase[F.tid] = rb - c; T.tb[F.tid] = tb - t;
        if (F.tid == NE - 1) { T.rowbase[NE] = rb; T.tb[NE] = tb; }
    }
    __syncthreads();
}
__device__ __forceinline__ void moe_tile(const MoeTab& T, int tile, Unit& u) {
    if (tile < 128) { u.e = NE; u.pm = tile * 256; u.rows = 256; return; }
    const int t = tile - 128; int lo = 0, hi = NE - 1;
    while (lo < hi) { const int mid = (lo + hi + 1) >> 1; if (T.tb[mid] <= t) lo = mid; else hi = mid - 1; }
    u.e = lo; const int rt = t - T.tb[lo]; u.pm = rt * 256; const int left = T.cnt[lo] - rt * 256; u.rows = left < 256 ? left : 256;
}
__device__ __forceinline__ void dense_unit(int L, int nM, int nN, Unit& u) {
    const int nwg = nM * nN; int wgid = L; { const int q = nwg / 8, r = nwg % 8, xcd = wgid % 8, off = wgid / 8; wgid = (xcd < r ? xcd * (q + 1) : r * (q + 1) + (xcd - r) * q) + off; }
    const int nig = 8 * nN, gid = wgid / nig, fm = gid * 8, gsz = (nM - fm) < 8 ? (nM - fm) : 8;
    u.pm = fm + ((wgid % nig) % gsz); u.pn = (wgid % nig) / gsz; u.e = 0; u.rows = 256;
}
__device__ __forceinline__ unsigned cvt_pk_bf16(float lo, float hi) { unsigned r; asm volatile("v_cvt_pk_bf16_f32 %0, %1, %2" : "=v"(r) : "v"(lo), "v"(hi)); return r; }
__device__ __forceinline__ v4u pack8(const f32x4& a, const f32x4& b) { v4u w; w.x = cvt_pk_bf16(a[0], a[1]); w.y = cvt_pk_bf16(a[2], a[3]); w.z = cvt_pk_bf16(b[0], b[1]); w.w = cvt_pk_bf16(b[2], b[3]); return w; }
typedef f32x4 AccT[2][2][4][2];
__device__ __forceinline__ int bcol_wide(int bj, int slot) { const int wc = slot >> 5, rho = slot & 31, n = rho >> 4, i = rho & 15; return 64 * wc + 16 * (i >> 2) + 8 * bj + 4 * n + (i & 3); }
__device__ __forceinline__ int bcol_split(int bj, int slot) { const int wc = slot >> 5, rho = slot & 31, n = rho >> 4, i = rho & 15; return 64 * wc + 32 * bj + 8 * (i >> 2) + 4 * n + (i & 3); }
__device__ __forceinline__ int bcol_pair(int bj, int slot) { const int rho = slot & 31, n = rho >> 4, i = rho & 15; return 128 * bj + (slot & ~31) + 8 * (i >> 2) + 4 * n + (i & 3); }

#ifndef STAGE_A_NT
#define STAGE_A_NT 3
#endif
#ifndef OUT_NT
#define OUT_NT 0
#endif
#if OUT_NT
#define OUT_STORE(v, p) __builtin_nontemporal_store((v), (p))
#else
#define OUT_STORE(v, p) (*(p) = (v))
#endif
#ifndef PROJ_NT
#define PROJ_NT 1
#endif
#if PROJ_NT
#define PROJ_STORE(v, p) __builtin_nontemporal_store((v), (p))
#else
#define PROJ_STORE(v, p) (*(p) = (v))
#endif
struct ProbIn {
    static constexpr bool A_NT = false;
    static constexpr int K = D; static constexpr bool PAIR = false, RAW_BX = true, FP8 = false; static constexpr int MSCALE = 127;
    const bf16* XN; const bf16* W; bf16* PROJ;
    __device__ __forceinline__ int nunits() const { return 128 * 14; }
    __device__ __forceinline__ void unit(int L, Unit& u, int = -1) const { dense_unit(L, 128, 14, u); }
    __device__ __forceinline__ const bf16* arow(const Unit& u, int r) const { return XN + (size_t)(u.pm * 256 + r) * D; }
    __device__ __forceinline__ const bf16* brow(const Unit& u, int c) const { return W + (size_t)(u.pn * 256 + c) * D; }
    __device__ __forceinline__ void store(const Unit& u, int r, int c, float v) const { PROJ[(size_t)(u.pm * 256 + r) * PW + u.pn * 256 + c] = (bf16)f2bf(v); }
    __device__ __forceinline__ const char* abase() const { return (const char*)XN; }
    __device__ __forceinline__ unsigned aoff(const Unit& u, int, int r, int c) const { return (unsigned)((u.pm * 256 + r) * D + c) * 2u; }
    __device__ __forceinline__ const char* bbase(const Unit& u) const { return (const char*)(W + (size_t)u.pn * 256 * D); }
    static __device__ __forceinline__ int bcol(int bj, int slot) { return bcol_split(bj, slot); }
    __device__ __forceinline__ void epi(const AccT& acc, const Unit& u, int wr, int wc, int fr, int fq) const {
#pragma unroll
        for (int ai = 0; ai < 2; ++ai)
#pragma unroll
            for (int m = 0; m < 4; ++m) {
                const v4u w0 = pack8(acc[ai][0][m][0], acc[ai][0][m][1]), w1 = pack8(acc[ai][1][m][0], acc[ai][1][m][1]);
                const bool odd = fr & 1;
                const v4u snd = odd ? w0 : w1; v4u rcv;
                rcv.x = (unsigned)__builtin_amdgcn_mov_dpp((int)snd.x, 0xB1, 0xF, 0xF, true); rcv.y = (unsigned)__builtin_amdgcn_mov_dpp((int)snd.y, 0xB1, 0xF, 0xF, true);
                rcv.z = (unsigned)__builtin_amdgcn_mov_dpp((int)snd.z, 0xB1, 0xF, 0xF, true); rcv.w = (unsigned)__builtin_amdgcn_mov_dpp((int)snd.w, 0xB1, 0xF, 0xF, true);
                bf16* rowp = PROJ + (size_t)(u.pm * 256 + 128 * ai + 64 * wr + 16 * m + (fr & ~1)) * PW + u.pn * 256 + 64 * wc + 8 * fq + (odd ? 32 : 0);
                PROJ_STORE(odd ? rcv : w0, (v4u*)rowp); PROJ_STORE(odd ? w1 : rcv, (v4u*)(rowp + PW)); }
    }
};
struct ProbOut {
    static constexpr bool A_NT = (STAGE_A_NT & 1) != 0;
    static constexpr int K = D; static constexpr bool PAIR = false, RAW_BX = true, FP8 = false; static constexpr int MSCALE = 127;
    const bf16* Y; const bf16* W; const float* x; bf16* H1; float* sumsq; unsigned char* H1q; const bf16* XNr; const float* rinv;
    __device__ __forceinline__ int nunits() const { return 128 * 4; }
    __device__ __forceinline__ void unit(int L, Unit& u, int = -1) const { dense_unit(L, 128, 4, u); }
    __device__ __forceinline__ const bf16* arow(const Unit& u, int r) const { return Y + (size_t)(u.pm * 256 + r) * D; }
    __device__ __forceinline__ const bf16* brow(const Unit& u, int c) const { return W + (size_t)(u.pn * 256 + c) * D; }
    __device__ __forceinline__ const char* abase() const { return (const char*)Y; }
    __device__ __forceinline__ unsigned aoff(const Unit& u, int, int r, int c) const { return (unsigned)((u.pm * 256 + r) * D + c) * 2u; }
    __device__ __forceinline__ const char* bbase(const Unit& u) const { return (const char*)(W + (size_t)u.pn * 256 * D); }
    static __device__ __forceinline__ int bcol(int bj, int slot) { return bcol_split(bj, slot); }
    static __device__ __forceinline__ v4u swap4(const v4u& a) { v4u r; r.x = (unsigned)__builtin_amdgcn_mov_dpp((int)a.x, 0xB1, 0xF, 0xF, true); r.y = (unsigned)__builtin_amdgcn_mov_dpp((int)a.y, 0xB1, 0xF, 0xF, true);
        r.z = (unsigned)__builtin_amdgcn_mov_dpp((int)a.z, 0xB1, 0xF, 0xF, true); r.w = (unsigned)__builtin_amdgcn_mov_dpp((int)a.w, 0xB1, 0xF, 0xF, true); return r; }
    __device__ __forceinline__ void epi(const AccT& acc, const Unit& u, int wr, int wc, int fr, int fq) const {
        const bool odd = fr & 1;
#pragma unroll
        for (int ai = 0; ai < 2; ++ai)
#pragma unroll
            for (int m = 0; m < 4; ++m) {
                const int rowe = u.pm * 256 + 128 * ai + 64 * wr + 16 * m + (fr & ~1), row = rowe + (odd ? 1 : 0);
                const size_t oe = (size_t)rowe * D + u.pn * 256 + 64 * wc + 8 * fq + (odd ? 32 : 0);
                const float ri = rinv[row];
                const v4u la = *(const v4u*)(XNr + oe), lb = *(const v4u*)(XNr + oe + D);
                const v4u xr = swap4(odd ? la : lb);
                const v4u xw[2] = {odd ? xr : la, odd ? lb : xr};
                float ss = 0.f; v4u hw[2]; v2u q8[2];
#pragma unroll
                for (int bj = 0; bj < 2; ++bj) {
                    const f32x4 x0 = (f32x4){bflo(xw[bj].x), bfhi(xw[bj].x), bflo(xw[bj].y), bfhi(xw[bj].y)} * ri, x1 = (f32x4){bflo(xw[bj].z), bfhi(xw[bj].z), bflo(xw[bj].w), bfhi(xw[bj].w)} * ri;
                    const f32x4 v0 = acc[ai][bj][m][0] + x0, v1 = acc[ai][bj][m][1] + x1;
                    ss += (v0[0] * v0[0] + v0[1] * v0[1]) + (v0[2] * v0[2] + v0[3] * v0[3]) + (v1[0] * v1[0] + v1[1] * v1[1]) + (v1[2] * v1[2] + v1[3] * v1[3]);
                    hw[bj] = pack8(v0, v1);
                    if (H1q) { int w0 = __builtin_amdgcn_cvt_pk_fp8_f32(v0[0], v0[1], 0, false); w0 = __builtin_amdgcn_cvt_pk_fp8_f32(v0[2], v0[3], w0, true);
                        int w1 = __builtin_amdgcn_cvt_pk_fp8_f32(v1[0], v1[1], 0, false); w1 = __builtin_amdgcn_cvt_pk_fp8_f32(v1[2], v1[3], w1, true);
                        q8[bj] = (v2u){(unsigned)w0, (unsigned)w1}; }
                }
                { const v4u hr = swap4(odd ? hw[0] : hw[1]);
                  *(v4u*)(H1 + oe) = odd ? hr : hw[0]; *(v4u*)(H1 + oe + D) = odd ? hw[1] : hr; }
                if (H1q) { const v2u qs = odd ? q8[0] : q8[1]; v2u qr; qr.x = (unsigned)__builtin_amdgcn_mov_dpp((int)qs.x, 0xB1, 0xF, 0xF, true); qr.y = (unsigned)__builtin_amdgcn_mov_dpp((int)qs.y, 0xB1, 0xF, 0xF, true);
                  *(v2u*)(H1q + oe) = odd ? qr : q8[0]; *(v2u*)(H1q + oe + D) = odd ? q8[1] : qr; }
                ss += __shfl_xor(ss, 16); ss += __shfl_xor(ss, 32);
                if (fq == 0) atomicAdd(sumsq + row, ss);
            }
    }
};
struct ProbE1 {
    static constexpr bool FP8 = (FP8_E1 != 0) && ((FAST_GEMM & 4) != 0), PAIR = true, RAW_BX = false;
    static constexpr bool A_NT = false;
    static constexpr int MSCALE = 122;
    static_assert(WQ_SCALE == 32.f, "MSCALE assumes WQ_SCALE = 32");
    static constexpr int K = FP8 ? D / 2 : D;
    MoeTab T; const bf16* H1; const bf16* WGU; const int* tok; const f32x2* scl; const f32x2* scls; bf16* HID; LAS int* idx;
    __device__ __forceinline__ int nunits() const { return (128 + T.tb[NE]) * 2; }
    LAS int* ut = nullptr;
    __device__ __forceinline__ void unit(int i, Unit& u, int slot = -1) const { if (slot >= 0 && ut) { const LAS int* q = ut + 4 * slot; u.e = q[0]; u.pm = q[1]; u.rows = q[2]; u.pn = q[3]; return; } moe_tile(T, i >> 1, u); u.pn = i & 1; }
    __device__ __forceinline__ int token(const Unit& u, int r) const { if (u.e == NE) return u.pm + r; const int rr = (r < u.rows) ? u.pm + r : u.pm; return tok[(size_t)u.e * NTOK + rr]; }
    __device__ __forceinline__ const bf16* arow(const Unit& u, int r) const { return H1 + (size_t)token(u, r) * D; }
    __device__ __forceinline__ const bf16* brow(const Unit& u, int c) const { return WGU + ((size_t)u.e * 512 + u.pn * 256 + c) * D; }
    __device__ __forceinline__ size_t hidrow(const Unit& u, int r) const { return (u.e == NE) ? (size_t)(u.pm + r) : (size_t)(NTOK + T.rowbase[u.e] + u.pm + r); }
    __device__ __forceinline__ f32x2 scale(const Unit& u, int r) const { return (u.e == NE) ? scls[u.pm + r] : scl[(size_t)u.e * NTOK + u.pm + r]; }
    __device__ __forceinline__ void store2(const Unit& u, int r, int c, float g, float up) const {
        if (r >= u.rows) return;
        const f32x2 sc = scale(u, r);
        HID[hidrow(u, r) * FF + u.pn * 128 + c] = (bf16)f2bf(siluf_(g * sc.x) * up * sc.y);
    }
    __device__ __forceinline__ const char* abase() const { return (const char*)H1; }
    __device__ __forceinline__ unsigned aoff(const Unit& u, int slot, int r, int c) const { const int t = (u.e == NE) ? u.pm + r : idx[slot * 256 + r]; return (unsigned)(t * K + c) * 2u; }
    __device__ __forceinline__ const char* bbase(const Unit& u) const { return (const char*)WGU + ((size_t)u.e * 512 + u.pn * 256) * K * 2; }
    static __device__ __forceinline__ int bcol(int bj, int slot) { return bcol_pair(bj, slot); }
    __device__ __forceinline__ void epi(const AccT& acc, const Unit& u, int wr, int wc, int fr, int fq) const {
        const size_t hb = hidrow(u, 0);
#pragma unroll
        for (int ai = 0; ai < 2; ++ai)
#pragma unroll
            for (int m = 0; m < 4; ++m) {
                const int r = 128 * ai + 64 * wr + 16 * m + fr;
                if (r < u.rows) {
                    f32x2 sc = scale(u, r); if (ProbE2Q) sc.y *= HQ_SCALE;
                    f32x4 h0, h1;
#pragma unroll
                    for (int j = 0; j < 4; ++j) { h0[j] = siluf_(acc[ai][0][m][0][j] * sc.x) * acc[ai][1][m][0][j] * sc.y; h1[j] = siluf_(acc[ai][0][m][1][j] * sc.x) * acc[ai][1][m][1][j] * sc.y; }
                    if (ProbE2Q) {
#pragma unroll
                        for (int j = 0; j < 4; ++j) { h0[j] = __builtin_amdgcn_fmed3f(h0[j], -F8MAX, F8MAX); h1[j] = __builtin_amdgcn_fmed3f(h1[j], -F8MAX, F8MAX); }
                        int w0 = __builtin_amdgcn_cvt_pk_fp8_f32(h0[0], h0[1], 0, false); w0 = __builtin_amdgcn_cvt_pk_fp8_f32(h0[2], h0[3], w0, true);
                        int w1 = __builtin_amdgcn_cvt_pk_fp8_f32(h1[0], h1[1], 0, false); w1 = __builtin_amdgcn_cvt_pk_fp8_f32(h1[2], h1[3], w1, true);
                        *(v2u*)((unsigned char*)HID + (hb + r) * FF + u.pn * 128 + 32 * wc + 8 * fq) = (v2u){(unsigned)w0, (unsigned)w1}; }
                    else *(v4u*)(HID + (hb + r) * FF + u.pn * 128 + 32 * wc + 8 * fq) = pack8(h0, h1);
                }
            }
    }
};
struct ProbE2 {
    static constexpr bool PAIR = false, RAW_BX = false, FP8 = ProbE2Q;
    static constexpr bool A_NT = (STAGE_A_NT & 2) != 0;
    static constexpr int MSCALE = FP8 ? 124 : 127;
    static_assert(YSCALE * 8.f == HQ_SCALE * WDQ_SCALE, "MSCALE assumes YSCALE / (HQ_SCALE * WDQ_SCALE) = 1/8");
    static constexpr int K = FP8 ? FF / 2 : FF;
    MoeTab T; const bf16* HID; const bf16* WD; unsigned char* YS; unsigned char* YR; int t0; int ntl;
    __device__ __forceinline__ int nunits() const { return (ntl > 0 ? ntl : 128 - t0 + T.tb[NE]) * 4; }
    LAS int* ut = nullptr;
    __device__ __forceinline__ void unit(int i, Unit& u, int slot = -1) const { if (slot >= 0 && ut) { const LAS int* q = ut + 4 * slot; u.e = q[0]; u.pm = q[1]; u.rows = q[2]; u.pn = q[3]; return; } moe_tile(T, (i >> 2) + t0, u); u.pn = i & 3; }
    __device__ __forceinline__ size_t hidrow(const Unit& u, int r) const { return (u.e == NE) ? (size_t)(u.pm + r) : (size_t)(NTOK + T.rowbase[u.e] + u.pm + r); }
    __device__ __forceinline__ const bf16* arow(const Unit& u, int r) const { return HID + hidrow(u, r) * FF; }
    __device__ __forceinline__ const bf16* brow(const Unit& u, int c) const { return WD + ((size_t)u.e * D + u.pn * 256 + c) * FF; }
    __device__ __forceinline__ void store(const Unit& u, int r, int c, float v) const {
        if (r >= u.rows) return;
        if (u.e == NE) { const int w = __builtin_amdgcn_cvt_pk_fp8_f32(v * YSCALE, 0.f, 0, false); YS[(size_t)(u.pm + r) * D + u.pn * 256 + c] = (unsigned char)(w & 0xff); }
        else { const int w = __builtin_amdgcn_cvt_pk_fp8_f32(v * YSCALE, 0.f, 0, false); YR[(size_t)(T.rowbase[u.e] + u.pm + r) * D + u.pn * 256 + c] = (unsigned char)(w & 0xff); }
    }
    __device__ __forceinline__ const char* abase() const { return (const char*)HID; }
    __device__ __forceinline__ unsigned aoff(const Unit& u, int, int r, int c) const { return (unsigned)(((unsigned)hidrow(u, 0) + (unsigned)r) * K + c) * 2u; }
    __device__ __forceinline__ const char* bbase(const Unit& u) const { return (const char*)WD + ((size_t)u.e * D + u.pn * 256) * K * 2; }
    static __device__ __forceinline__ int bcol(int bj, int slot) { return bcol_wide(bj, slot); }
    __device__ __forceinline__ void epi(const AccT& acc, const Unit& u, int wr, int wc, int fr, int fq) const {
        const int cb = u.pn * 256 + 64 * wc + 16 * fq;
        constexpr float dq = FP8 ? 1.f / (HQ_SCALE * WDQ_SCALE) : 1.f;
        unsigned char* yb = (u.e == NE) ? YS : YR; const int row0 = (u.e == NE) ? u.pm : T.rowbase[u.e] + u.pm;
#pragma unroll
        for (int ai = 0; ai < 2; ++ai)
#pragma unroll
            for (int m = 0; m < 4; ++m) {
                const int r = 128 * ai + 64 * wr + 16 * m + fr;
                if (r < u.rows) {
                    v4u w;
#pragma unroll
                    for (int bj = 0; bj < 2; ++bj) { f32x4 v0 = acc[ai][bj][m][0], v1 = acc[ai][bj][m][1]; if (!FP8) { v0 *= YSCALE; v1 *= YSCALE; }
#pragma unroll
                        for (int j = 0; j < 4; ++j) { v0[j] = __builtin_amdgcn_fmed3f(v0[j], -F8MAX, F8MAX); v1[j] = __builtin_amdgcn_fmed3f(v1[j], -F8MAX, F8MAX); }
                        int w0 = __builtin_amdgcn_cvt_pk_fp8_f32(v0[0], v0[1], 0, false); w0 = __builtin_amdgcn_cvt_pk_fp8_f32(v0[2], v0[3], w0, true);
                        int w1 = __builtin_amdgcn_cvt_pk_fp8_f32(v1[0], v1[1], 0, false); w1 = __builtin_amdgcn_cvt_pk_fp8_f32(v1[2], v1[3], w1, true);
                        if (bj == 0) { w.x = (unsigned)w0; w.y = (unsigned)w1; } else { w.z = (unsigned)w0; w.w = (unsigned)w1; } }
                    __builtin_nontemporal_store(w, (v4u*)(yb + (size_t)(row0 + r) * D + cb));
                }
            }
    }
};

template <class P>
__device__ __forceinline__ void simple_gemm_phase(Frame& F, const P& p, int Geff = 0) {
    const int lane = F.lane, fr = lane & 15, fq = lane >> 4, w = F.wave;
    const int nu = p.nunits();
    const int G = Geff ? Geff : F.G, c0 = (P::RAW_BX ? (int)blockIdx.x : F.vcu);
    if (c0 >= G) return;
    for (int i = c0; i < nu; i += G) {
        Unit u; p.unit(i, u);
        f32x4 acc[2][16];
#pragma unroll
        for (int a = 0; a < 2; ++a)
#pragma unroll
            for (int n = 0; n < 16; ++n) acc[a][n] = (f32x4){0.f, 0.f, 0.f, 0.f};
        const bf16* ap[2]; ap[0] = p.arow(u, 32 * w + fr) + 8 * fq; ap[1] = p.arow(u, 32 * w + 16 + fr) + 8 * fq;
        const bf16* bp = p.brow(u, fr) + 8 * fq;
        for (int k0 = 0; k0 < P::K; k0 += 32) {
            const bf16x8 a0 = *(const bf16x8*)(ap[0] + k0), a1 = *(const bf16x8*)(ap[1] + k0);
#pragma unroll
            for (int n = 0; n < 16; ++n) {
                const bf16x8 b = *(const bf16x8*)(bp + (size_t)(16 * n) * P::K + k0);
                acc[0][n] = __builtin_amdgcn_mfma_f32_16x16x32_bf16(a0, b, acc[0][n], 0, 0, 0);
                acc[1][n] = __builtin_amdgcn_mfma_f32_16x16x32_bf16(a1, b, acc[1][n], 0, 0, 0);
            }
        }
#pragma unroll
        for (int a = 0; a < 2; ++a)
#pragma unroll
            for (int j = 0; j < 4; ++j) {
                const int r = 32 * w + 16 * a + 4 * fq + j;
                if constexpr (P::PAIR) {
#pragma unroll
                    for (int n = 0; n < 8; ++n) p.store2(u, r, 16 * n + fr, acc[a][n][j], acc[a][n + 8][j]);
                } else {
#pragma unroll
                    for (int n = 0; n < 16; ++n) p.store(u, r, 16 * n + fr, acc[a][n][j]);
                }
            }
    }
}
__device__ __forceinline__ void simple_gemm_out(Frame& F, const ProbOut& p) {
    const int lane = F.lane, fr = lane & 15, fq = lane >> 4, w = F.wave;
    for (int i = blockIdx.x; i < p.nunits(); i += F.G) {
        Unit u; p.unit(i, u);
        f32x4 acc[2][16];
#pragma unroll
        for (int a = 0; a < 2; ++a)
#pragma unroll
            for (int n = 0; n < 16; ++n) acc[a][n] = (f32x4){0.f, 0.f, 0.f, 0.f};
        const bf16* ap0 = p.arow(u, 32 * w + fr) + 8 * fq; const bf16* ap1 = p.arow(u, 32 * w + 16 + fr) + 8 * fq;
        const bf16* bp = p.brow(u, fr) + 8 * fq;
        for (int k0 = 0; k0 < D; k0 += 32) {
            const bf16x8 a0 = *(const bf16x8*)(ap0 + k0), a1 = *(const bf16x8*)(ap1 + k0);
#pragma unroll
            for (int n = 0; n < 16; ++n) {
                const bf16x8 b = *(const bf16x8*)(bp + (size_t)(16 * n) * D + k0);
                acc[0][n] = __builtin_amdgcn_mfma_f32_16x16x32_bf16(a0, b, acc[0][n], 0, 0, 0);
                acc[1][n] = __builtin_amdgcn_mfma_f32_16x16x32_bf16(a1, b, acc[1][n], 0, 0, 0);
            }
        }
#pragma unroll
        for (int a = 0; a < 2; ++a)
#pragma unroll
            for (int j = 0; j < 4; ++j) {
                const int row = u.pm * 256 + 32 * w + 16 * a + 4 * fq + j;
                float ss = 0.f;
#pragma unroll
                for (int n = 0; n < 16; ++n) { const int col = u.pn * 256 + 16 * n + fr; const float v = p.x[(size_t)row * D + col] + acc[a][n][j]; p.H1[(size_t)row * D + col] = (bf16)f2bf(v); ss += v * v; }
                ss += __shfl_xor(ss, 1); ss += __shfl_xor(ss, 2); ss += __shfl_xor(ss, 4); ss += __shfl_xor(ss, 8);
                if (fr == 0) atomicAdd(p.sumsq + row, ss);
            }
    }
}

namespace fg {
constexpr int BK = 64, HALF = 128, HTB = HALF * BK * 2;
__device__ __forceinline__ int lds_byte(int r, int c) { const int st = (r >> 4) * 2 + (c >> 5), rr = r & 15, cc = c & 31, ob = rr * 64 + cc * 2; return st * 1024 + (ob ^ (((ob >> 9) & 1) << 5)); }
__device__ __forceinline__ void stage_rc(int b, int& R, int& C) { const int st = b / 1024, sb = b % 1024, swz = sb ^ (((sb >> 9) & 1) << 5); R = (st >> 1) * 16 + swz / 64; C = (st & 1) * 32 + (swz % 64) / 2; }
__device__ __forceinline__ int perm32(int rho) { const int n = rho >> 4, i = rho & 15; return 8 * (i >> 2) + 4 * n + (i & 3); }

typedef int v8i __attribute__((ext_vector_type(8)));
typedef int v4i __attribute__((ext_vector_type(4)));
__device__ __forceinline__ const char* uptr(const char* p) { const unsigned long long v = (unsigned long long)p; const unsigned lo = __builtin_amdgcn_readfirstlane((unsigned)v), hi = __builtin_amdgcn_readfirstlane((unsigned)(v >> 32)); return (const char*)(((unsigned long long)hi << 32) | lo); }
template <class P>
__device__ __forceinline__ void gemm_phase(Frame& F, const P& p, int Geff = 0) {
    constexpr int K = P::K, nt = K / BK;
    LAS unsigned char* lds = F.lds;
    const int tid = F.tid, wid = F.wave, lane = F.lane, wr = wid >> 2, wc = wid & 3, fr = lane & 15, fq = lane >> 4;
    const int nu = p.nunits(), c0 = P::RAW_BX ? (int)blockIdx.x : F.vcu, G = Geff ? Geff : F.G;
    if (c0 >= nu || c0 >= G) return;
    unsigned voffB[2][2];
#pragma unroll
    for (int i = 0; i < 2; ++i) { int R, C; stage_rc(tid * 16 + i * 8192, R, C);
#pragma unroll
        for (int bj = 0; bj < 2; ++bj) voffB[bj][i] = (unsigned)(P::bcol(bj, R) * K + C) * 2u; }
    constexpr size_t kstep = (size_t)(BK * 2);
    const unsigned ldsw = (unsigned)wid * 1024u;
    const int aoff = lds_byte(wr * 64 + fr, fq * 8), boff = lds_byte(wc * 32 + fr, fq * 8);
#define FG_SA(b, h) (((b) * 2 + (h)) * HTB)
#define FG_SB(b, h) ((4 + (b) * 2 + (h)) * HTB)
#define FG_STAGE(bufoff, gbase, voff) do { _Pragma("unroll") for (int _i = 0; _i < 2; ++_i) { unsigned _v = (voff)[_i]; asm volatile("" : "+v"(_v));     \
        __builtin_amdgcn_global_load_lds((const unsigned*)((const char*)(gbase) + _v), (LAS unsigned*)(lds + (bufoff) + ldsw + _i * 8192), 16, 0, 0); } } while (0)
#define FG_STAGE_A(bufoff, gbase, voff) do { _Pragma("unroll") for (int _i = 0; _i < 2; ++_i) { unsigned _v = (voff)[_i]; asm volatile("" : "+v"(_v)); \
        __builtin_amdgcn_global_load_lds((const unsigned*)((const char*)(gbase) + _v), (LAS unsigned*)(lds + (bufoff) + ldsw + _i * 8192), 16, 0, P::A_NT ? 2 : 0); } } while (0)
#define FG_LDA(dst, b, h) do { _Pragma("unroll") for (int m = 0; m < 4; ++m) { dst[m].lo = *(const LAS v4i*)(lds + FG_SA(b, h) + aoff + m * 2048); dst[m].hi = *(const LAS v4i*)(lds + FG_SA(b, h) + aoff + m * 2048 + 1024); } } while (0)
#define FG_LDB(dst, b, h) do { _Pragma("unroll") for (int n = 0; n < 2; ++n) { dst[n].lo = *(const LAS v4i*)(lds + FG_SB(b, h) + boff + n * 2048); dst[n].hi = *(const LAS v4i*)(lds + FG_SB(b, h) + boff + n * 2048 + 1024); } } while (0)
#define FG_MMA(ai, bj, At, Bt) do { __builtin_amdgcn_s_setprio(1); _Pragma("unroll") for (int m = 0; m < 4; ++m) _Pragma("unroll") for (int n = 0; n < 2; ++n) { \
        if constexpr (P::FP8) acc[ai][bj][m][n] = __builtin_amdgcn_mfma_scale_f32_16x16x128_f8f6f4(Bt[n], At[m], acc[ai][bj][m][n], 0, 0, 0, P::MSCALE, 0, 127); \
        else { acc[ai][bj][m][n] = __builtin_amdgcn_mfma_f32_16x16x32_bf16(__builtin_bit_cast(bf16x8, (v4i)Bt[n].lo), __builtin_bit_cast(bf16x8, (v4i)At[m].lo), acc[ai][bj][m][n], 0, 0, 0); \
               acc[ai][bj][m][n] = __builtin_amdgcn_mfma_f32_16x16x32_bf16(__builtin_bit_cast(bf16x8, (v4i)Bt[n].hi), __builtin_bit_cast(bf16x8, (v4i)At[m].hi), acc[ai][bj][m][n], 0, 0, 0); } } __builtin_amdgcn_s_setprio(0); } while (0)
#define FG_WAIT_V(n) asm volatile("s_waitcnt vmcnt(" #n ")" ::: "memory")
#define FG_WAIT_L(n) asm volatile("s_waitcnt lgkmcnt(" #n ")" ::: "memory")
#define FG_BAR __builtin_amdgcn_s_barrier()
#define FG_SCHED __builtin_amdgcn_sched_barrier(0)
#define FG_AOFFS(dst, u, slot) do { int _t = tid; asm volatile("" : "+v"(_t)); _Pragma("unroll") for (int _i = 0; _i < 2; ++_i) { int _R, _C; stage_rc(_t * 16 + _i * 8192, _R, _C); \
        _Pragma("unroll") for (int _h = 0; _h < 2; ++_h) dst[_h][_i] = p.aoff(u, slot, 128 * _h + _R, _C); } } while (0)
    Unit cur, nxt; int ui = 0;
    p.unit(c0, cur, 0);
    cur.pm = __builtin_amdgcn_readfirstlane(cur.pm); cur.pn = __builtin_amdgcn_readfirstlane(cur.pn); cur.e = __builtin_amdgcn_readfirstlane(cur.e); cur.rows = __builtin_amdgcn_readfirstlane(cur.rows);
    unsigned cvo[2][2];
    FG_AOFFS(cvo, cur, 0);
    AccT acc;
#pragma unroll
    for (int a = 0; a < 2; ++a)
#pragma unroll
        for (int b = 0; b < 2; ++b)
#pragma unroll
            for (int m = 0; m < 4; ++m)
#pragma unroll
                for (int n = 0; n < 2; ++n) acc[a][b][m][n] = (f32x4){0.f, 0.f, 0.f, 0.f};
    v8i At[4], B0[2], B1[2];
    const char* const Ab = p.abase();
    const char* cB = p.bbase(cur);
    FG_STAGE(FG_SB(0, 0), cB, voffB[0]); FG_STAGE(FG_SB(0, 1), cB, voffB[1]); FG_STAGE_A(FG_SA(0, 0), Ab, cvo[0]); FG_STAGE_A(FG_SA(0, 1), Ab, cvo[1]);
    if (wr == 1) FG_BAR;
    FG_WAIT_V(2); FG_BAR;
    FG_STAGE(FG_SB(1, 0), cB + kstep, voffB[0]); FG_STAGE_A(FG_SA(1, 0), Ab + kstep, cvo[0]); FG_STAGE(FG_SB(1, 1), cB + kstep, voffB[1]);
    FG_WAIT_V(6); FG_BAR;
    for (;;) {
        const int nidx = c0 + (ui + 1) * G;
        const bool has_next = nidx < nu;
        const char* nB = cB;
        if (has_next) {
            p.unit(nidx, nxt, ui + 1);
            nxt.pm = __builtin_amdgcn_readfirstlane(nxt.pm); nxt.pn = __builtin_amdgcn_readfirstlane(nxt.pn); nxt.e = __builtin_amdgcn_readfirstlane(nxt.e); nxt.rows = __builtin_amdgcn_readfirstlane(nxt.rows);
            nB = p.bbase(nxt);
        }
#pragma unroll 1
        for (int t = 0; t < nt; t += 2) {
            const bool last = (t == nt - 2);
            const char* a1 = uptr(Ab + (size_t)(t + 1) * kstep);
            const char* a2 = uptr(last ? Ab : Ab + (size_t)(t + 2) * kstep); const char* b2 = uptr(last ? nB : cB + (size_t)(t + 2) * kstep);
            const char* a3 = uptr(a2 + kstep); const char* b3 = uptr(b2 + kstep);
            FG_LDB(B0, 0, 0); FG_LDB(B1, 0, 1); FG_SCHED; FG_LDA(At, 0, 0); FG_STAGE_A(FG_SA(1, 1), a1, cvo[1]);
            if (last && has_next) FG_AOFFS(cvo, nxt, ui + 1);
            FG_WAIT_V(8); FG_WAIT_L(0); FG_BAR; FG_MMA(0, 0, At, B0); FG_MMA(0, 1, At, B1); FG_BAR; FG_SCHED;
            FG_LDA(At, 0, 1); FG_STAGE(FG_SB(0, 0), b2, voffB[0]); FG_STAGE(FG_SB(0, 1), b2, voffB[1]); FG_STAGE_A(FG_SA(0, 0), a2, cvo[0]);
            FG_WAIT_V(8); FG_WAIT_L(0); FG_BAR; FG_MMA(1, 0, At, B0); FG_MMA(1, 1, At, B1); FG_BAR; FG_SCHED;
            FG_LDB(B0, 1, 0); FG_LDB(B1, 1, 1); FG_SCHED; FG_LDA(At, 1, 0); FG_STAGE_A(FG_SA(0, 1), a2, cvo[1]);
            FG_WAIT_V(8); FG_WAIT_L(0); FG_BAR; FG_MMA(0, 0, At, B0); FG_MMA(0, 1, At, B1); FG_BAR; FG_SCHED;
            FG_LDA(At, 1, 1); FG_STAGE(FG_SB(1, 0), b3, voffB[0]); FG_STAGE(FG_SB(1, 1), b3, voffB[1]); FG_STAGE_A(FG_SA(1, 0), a3, cvo[0]);
            FG_WAIT_V(8); FG_WAIT_L(0); FG_BAR; FG_MMA(1, 0, At, B0); FG_MMA(1, 1, At, B1); FG_BAR; FG_SCHED;
        }
        if (wr == 0) FG_BAR;
        { int lne = lane; asm volatile("" : "+v"(lne));
          p.epi(acc, cur, wr, wc, lne & 15, lne >> 4); }
        if (!has_next) break;
#pragma unroll
        for (int a = 0; a < 2; ++a)
#pragma unroll
            for (int b = 0; b < 2; ++b)
#pragma unroll
                for (int m = 0; m < 4; ++m)
#pragma unroll
                    for (int n = 0; n < 2; ++n) acc[a][b][m][n] = (f32x4){0.f, 0.f, 0.f, 0.f};
        cur = nxt; cB = nB; ++ui;
        if (wr == 1) FG_BAR;
    }
    FG_WAIT_V(0);
    FG_BAR;
#undef FG_SA
#undef FG_SB
#undef FG_STAGE
#undef FG_STAGE_A
#undef FG_LDA
#undef FG_LDB
#undef FG_MMA
#undef FG_WAIT_V
#undef FG_WAIT_L
#undef FG_BAR
#undef FG_SCHED
#undef FG_AOFFS
}
}
namespace e2 {
typedef int v8i __attribute__((ext_vector_type(8)));
typedef int v4i __attribute__((ext_vector_type(4)));
__device__ __forceinline__ int sw(int row, int chunk) { return row * 256 + ((chunk ^ (row & 15)) << 4); }
struct Tile { int e, pm, rows; };
__device__ __forceinline__ void tile_of(const MoeTab& T, int tr, Tile& t) { Unit u; moe_tile(T, 128 + tr, u); t.e = __builtin_amdgcn_readfirstlane(u.e); t.pm = __builtin_amdgcn_readfirstlane(u.pm); t.rows = __builtin_amdgcn_readfirstlane(u.rows); }
__device__ __forceinline__ void load_a(v8i (&a)[2][2], const unsigned char* HIDq, const MoeTab& T, const Tile& t, int w, int lane) {
    const int fr = lane & 15, fq = lane >> 4; const char* base = fg::uptr((const char*)HIDq + (size_t)(NTOK + T.rowbase[t.e] + t.pm) * 256);
#pragma unroll
    for (int mt = 0; mt < 2; ++mt)
#pragma unroll
        for (int ks = 0; ks < 2; ++ks) { unsigned o = (unsigned)((32 * w + 16 * mt + fr) * 256 + 16 * (8 * ks + fq)); asm volatile("" : "+v"(o));
            a[mt][ks].lo = *(const v4i*)(base + o); a[mt][ks].hi = *(const v4i*)(base + o + 64); }
}
__device__ __forceinline__ void phase(Frame& F, const MoeTab& T, const unsigned char* HIDq, const unsigned char* WD8, unsigned char* YR, unsigned char* dump) {
    LAS unsigned char* L = F.lds; const int lane = F.lane, w = F.wave;
    const int ntr = T.tb[NE];
    if (F.vcu >= ntr) return;
    const int ntl = (ntr - F.vcu + F.G - 1) / F.G, nh = 8 * ntl;
    Tile cur, nxt; tile_of(T, F.vcu, cur); nxt = cur;
#define E2_STAGE_B(g, te) do { const int _hf = (g) & 7; const char* _bb = fg::uptr((const char*)WD8 + (size_t)(te) * D * 256); const int _rg = ln >> 4, _pc = ln & 15; \
        _Pragma("unroll") for (int i = 0; i < 4; ++i) { const int s = 16 * w + 4 * i + _rg, col = 32 * ((s & 15) >> 2) + 4 * (s >> 4) + (s & 3); \
            unsigned bo = (unsigned)((128 * _hf + col) * 256 + 16 * (_pc ^ (s & 15))); asm volatile("" : "+v"(bo)); \
            __builtin_amdgcn_global_load_lds((const unsigned*)(_bb + bo), (LAS unsigned*)(L + ((g) & 3) * 32768 + (16 * w + 4 * i) * 256), 16, 0, 0); } } while (0)
    v8i a[2][2], a2[2][2];
    { int ln = lane; asm volatile("" : "+v"(ln));
      E2_STAGE_B(0, cur.e); E2_STAGE_B(1, cur.e); E2_STAGE_B(2, cur.e); }
    load_a(a, HIDq, T, cur, w, lane);
#pragma unroll
    for (int mt = 0; mt < 2; ++mt)
#pragma unroll
        for (int ks = 0; ks < 2; ++ks) a2[mt][ks] = a[mt][ks];
    asm volatile("s_waitcnt vmcnt(0)" ::: "memory");
#pragma unroll 1
    for (int g = 0; g < nh; ++g) {
        int ln = lane; asm volatile("" : "+v"(ln)); const int fr = ln & 15, fq = ln >> 4;
        const int hf = g & 7;
        if (g + 3 > nh) asm volatile("s_waitcnt vmcnt(0)" ::: "memory"); else asm volatile("s_waitcnt vmcnt(20)" ::: "memory");
        WG_BARRIER();
        if (hf == 0 && g > 0) { cur = nxt; }
        if (hf == 4) { const int k1 = (g >> 3) + 1; if (k1 < ntl) tile_of(T, F.vcu + k1 * F.G, nxt); }
        if (g + 3 < nh) { const int te = ((g + 3) >> 3) == (g >> 3) ? cur.e : nxt.e; E2_STAGE_B(g + 3, te); }
        else {
            E2_STAGE_B(g + 3, cur.e); }
        if (hf == 5 && (g >> 3) + 1 < ntl) load_a(a2, HIDq, T, nxt, w, ln);
        f32x4 acc[2][8];
#pragma unroll
        for (int mt = 0; mt < 2; ++mt)
#pragma unroll
            for (int nt = 0; nt < 8; ++nt) acc[mt][nt] = (f32x4){0.f, 0.f, 0.f, 0.f};
        const LAS unsigned char* Bq = L + (g & 3) * 32768;
#pragma unroll
        for (int ks = 0; ks < 2; ++ks)
#pragma unroll
            for (int nt = 0; nt < 8; ++nt) {
                v8i b; b.lo = *(const LAS v4i*)(Bq + sw(16 * nt + fr, 8 * ks + fq)); b.hi = *(const LAS v4i*)(Bq + sw(16 * nt + fr, 8 * ks + 4 + fq));
                acc[0][nt] = __builtin_amdgcn_mfma_scale_f32_16x16x128_f8f6f4(b, a[0][ks], acc[0][nt], 0, 0, 0, 127, 0, 127);
                acc[1][nt] = __builtin_amdgcn_mfma_scale_f32_16x16x128_f8f6f4(b, a[1][ks], acc[1][nt], 0, 0, 0, 127, 0, 127);
            }
        constexpr float dq = YSCALE / (HQ_SCALE * WDQ_SCALE);
#pragma unroll
        for (int mt = 0; mt < 2; ++mt) {
            const int r = 32 * w + 16 * mt + fr;
            unsigned char* p = (r < cur.rows) ? YR + (size_t)(T.rowbase[cur.e] + cur.pm + r) * D + 128 * hf + 32 * fq : dump + (size_t)F.tid * 32;
#pragma unroll
            for (int q = 0; q < 2; ++q) { unsigned wd[4];
#pragma unroll
                for (int x = 0; x < 4; ++x) { const f32x4 v = acc[mt][4 * q + x] * dq; int t = __builtin_amdgcn_cvt_pk_fp8_f32(v[0], v[1], 0, false); t = __builtin_amdgcn_cvt_pk_fp8_f32(v[2], v[3], t, true); wd[x] = (unsigned)t; }
                *(v4u*)(p + 16 * q) = (v4u){wd[0], wd[1], wd[2], wd[3]}; }
        }
        if (hf == 7) {
#pragma unroll
            for (int mt = 0; mt < 2; ++mt)
#pragma unroll
                for (int ks = 0; ks < 2; ++ks) a[mt][ks] = a2[mt][ks];
        }
    }
#undef E2_STAGE_B
    asm volatile("s_waitcnt vmcnt(0)" ::: "memory");
    WG_BARRIER();
}
}

template <class P>
__device__ __forceinline__ void moe_fill_units(Frame& F, P& p, LAS int* ut) {
    const int nu = p.nunits(), slot = F.tid, i = F.vcu + slot * F.G;
    if (i < nu) { Unit u; p.unit(i, u); ut[4 * slot] = u.e; ut[4 * slot + 1] = u.pm; ut[4 * slot + 2] = u.rows; ut[4 * slot + 3] = u.pn; }
    __syncthreads();
    p.ut = ut;
}
__device__ __forceinline__ void e1_fill_idx(Frame& F, const ProbE1& p) {
    const int nu = p.nunits(), G = F.G;
    int tv[11];
#pragma unroll
    for (int slot = 0; slot < 11; ++slot) { const int i = F.vcu + slot * G; tv[slot] = 0;
        if (i < nu && F.tid < 256) { Unit u; p.unit(i, u, slot); tv[slot] = p.token(u, F.tid); } }
#pragma unroll
    for (int slot = 0; slot < 11; ++slot) { const int i = F.vcu + slot * G; if (i < nu && F.tid < 256) p.idx[slot * 256 + F.tid] = tv[slot]; }
    __syncthreads();
}

__device__ __forceinline__ void hgrn_naive(Frame& F) {
    const bf16* PROJ = (const bf16*)(F.ws + WS_PROJ); const float* LB = (const float*)(F.ws + WS_LB); float* ORAW = (float*)(F.ws + WS_ORAW);
    LAS float* qs = (LAS float*)F.lds; LAS float* fs = qs + 2 * 512; LAS float* ks = fs + 2 * 512;
    const int tid = F.tid, h = tid >> 7;
    for (int b = F.vcu; b < NB; b += F.G) {
        float S[128];
#pragma unroll
        for (int d = 0; d < 128; ++d) S[d] = 0.f;
        const float lb = LB[tid];
        for (int t = 0; t < NMETA + SEQ; ++t) {
            const size_t row = (t < NMETA) ? (size_t)(NTOK + t) : (size_t)b * SEQ + (t - NMETA);
            const bf16* pr = PROJ + row * PW;
            const int buf = (t & 1) * 512;
            const float q = bf2f(pr[tid]), z = bf2f(pr[512 + tid]), iv = bf2f(pr[1024 + tid]);
            const float f = lb + (1.f - lb) * sigmoidf_(z);
            qs[buf + tid] = q; fs[buf + tid] = f; ks[buf + tid] = (1.f - lb) * sigmoidf_(-z);
            __syncthreads();
            float o = 0.f;
            const LAS f32x4* q4 = (const LAS f32x4*)(qs + buf + h * 128); const LAS f32x4* f4 = (const LAS f32x4*)(fs + buf + h * 128); const LAS f32x4* k4 = (const LAS f32x4*)(ks + buf + h * 128);
#pragma unroll
            for (int d4 = 0; d4 < 32; ++d4) {
                const f32x4 qq = q4[d4], ff = f4[d4], kk = k4[d4];
#pragma unroll
                for (int j = 0; j < 4; ++j) { S[4 * d4 + j] = ff[j] * S[4 * d4 + j] + kk[j] * iv; o += qq[j] * S[4 * d4 + j]; }
            }
            if (t >= NMETA) ORAW[row * HW + tid] = o;
        }
        __syncthreads();
    }
}

namespace hg {
constexpr int BF_OFF = 0, TOT_OFF = 32768, BMID_OFF = 34816, BLAST_OFF = 35328, QT_OFF = 36864, KT_OFF = 53248, QH_OFF = 69632, VT_OFF = 86016, PP_OFF = 102400, OI_OFF = QT_OFF, CONST_OFF = 110592;
typedef short v4i16_t __attribute__((ext_vector_type(4)));
__device__ __forceinline__ int offb(int row, int ch) { return 256 * row + 16 * (ch ^ (((row & 3) << 2) | ((row >> 2) & 3))); }
__device__ __forceinline__ int off8(int row, int chunk) { return row * 128 + ((chunk ^ (row & 7)) << 4); }
__device__ __forceinline__ void unpack8(const v4u& w, float (&f)[8]) { f[0] = bflo(w.x); f[1] = bfhi(w.x); f[2] = bflo(w.y); f[3] = bfhi(w.y); f[4] = bflo(w.z); f[5] = bfhi(w.z); f[6] = bflo(w.w); f[7] = bfhi(w.w); }
__device__ __forceinline__ bf16x8 rowfrag(const LAS unsigned char* img, int lane, int rb, int s) { return *(const LAS bf16x8*)(img + offb((lane & 15) + 16 * rb, 4 * s + (lane >> 4))); }
__device__ __forceinline__ bf16x8 trfrag(const LAS unsigned char* img, int lane, int c, int ks) {
    const int g = lane >> 4, q = (lane & 15) >> 2, p = lane & 3;
    const v4i16_t lo = __builtin_amdgcn_ds_read_tr16_b64_v4i16((LAS v4i16_t*)(img + offb(32 * ks + 8 * g + q, 2 * c + (p >> 1)) + 8 * (p & 1)));
    const v4i16_t hi = __builtin_amdgcn_ds_read_tr16_b64_v4i16((LAS v4i16_t*)(img + offb(32 * ks + 8 * g + 4 + q, 2 * c + (p >> 1)) + 8 * (p & 1)));
    return (bf16x8){lo[0], lo[1], lo[2], lo[3], hi[0], hi[1], hi[2], hi[3]};
}
struct Chunks { v4u z[2], q[2], v[2]; };
template <bool WANT_Q, bool WANT_V = true, bool NT = false>
__device__ __forceinline__ void load_chunks(Chunks& c, const bf16* PROJ, size_t row0, int h, int nvalid, int tid) {
    const int cc = tid & 15; const char* base = (const char*)PROJ;
#pragma unroll
    for (int jj = 0; jj < 2; ++jj) {
        const int s = (tid >> 4) + 32 * jj; const unsigned o = (unsigned)(((unsigned)row0 + (unsigned)s) * (unsigned)PW + (unsigned)(h * 128 + 8 * cc)) * 2u;
        if (s < nvalid) { c.z[jj] = NT ? __builtin_nontemporal_load((const v4u*)(base + o + 1024)) : *(const v4u*)(base + o + 1024); if (WANT_V) c.v[jj] = *(const v4u*)(base + o + 2048);
            if (WANT_Q) c.q[jj] = NT ? __builtin_nontemporal_load((const v4u*)(base + o)) : *(const v4u*)(base + o); else c.q[jj] = (v4u){0u, 0u, 0u, 0u}; }
        else { c.z[jj] = (v4u){0u, 0u, 0u, 0u}; if (WANT_V) c.v[jj] = (v4u){0u, 0u, 0u, 0u}; c.q[jj] = (v4u){0u, 0u, 0u, 0u}; }
    }
}
template <bool WANT_Q>
__device__ __forceinline__ void prep(Frame& F, const Chunks& c, const float* LB, int h, int nvalid, int tid_ = -1) {
    LAS unsigned char* L = F.lds; const int tid = tid_ >= 0 ? tid_ : F.tid;
    LAS float* BF = (LAS float*)(L + BF_OFF); LAS float* TOT = (LAS float*)(L + TOT_OFF); LAS float* BMID = (LAS float*)(L + BMID_OFF); LAS float* BLAST = (LAS float*)(L + BLAST_OFF);
    const int cc = tid & 15;
    float lb[8]; { const f32x4 a = *(const f32x4*)(LB + h * 128 + 8 * cc), b = *(const f32x4*)(LB + h * 128 + 8 * cc + 4); lb[0] = a.x; lb[1] = a.y; lb[2] = a.z; lb[3] = a.w; lb[4] = b.x; lb[5] = b.y; lb[6] = b.z; lb[7] = b.w; }
    float kreg[2][8];
#pragma unroll
    for (int jj = 0; jj < 2; ++jj) {
        if (jj == 1) __builtin_amdgcn_sched_barrier(0);
        const int s = (tid >> 4) + 32 * jj; float z[8]; unpack8(c.z[jj], z); f32x4 o0, o1;
#pragma unroll
        for (int e = 0; e < 8; ++e) { const float f = lb[e] + (1.f - lb[e]) * sigmoidf_(z[e]); const float lf = (s < nvalid) ? flog_(f) : 0.f; kreg[jj][e] = (s < nvalid) ? 1.f - f : 0.f; if (e < 4) o0[e] = lf; else o1[e - 4] = lf; }
        *(LAS f32x4*)(BF + s * 128 + 8 * cc) = o0; *(LAS f32x4*)(BF + s * 128 + 8 * cc + 4) = o1;
    }
    WG_BARRIER();
    {
        const int d = tid & 127, seg = tid >> 7; float run = 0.f;
#pragma unroll
        for (int i = 0; i < 16; ++i) run += BF[(16 * seg + i) * 128 + d];
        TOT[seg * 128 + d] = run;
        WG_BARRIER();
        const float t0 = TOT[d], t1 = TOT[128 + d], t2 = TOT[256 + d], t3 = TOT[384 + d];
        run = (seg > 0 ? t0 : 0.f) + (seg > 1 ? t1 : 0.f) + (seg > 2 ? t2 : 0.f);
#pragma unroll
        for (int i = 0; i < 16; ++i) { run += BF[(16 * seg + i) * 128 + d]; BF[(16 * seg + i) * 128 + d] = run; }
        if (seg == 0) { BMID[d] = t0 + t1; BLAST[d] = (t0 + t1) + (t2 + t3); }
    }
    WG_BARRIER();
    float bm[8]; { const f32x4 a = *(const LAS f32x4*)(BMID + 8 * cc), b = *(const LAS f32x4*)(BMID + 8 * cc + 4); bm[0] = a.x; bm[1] = a.y; bm[2] = a.z; bm[3] = a.w; bm[4] = b.x; bm[5] = b.y; bm[6] = b.z; bm[7] = b.w; }
#pragma unroll
    for (int jj = 0; jj < 2; ++jj) {
        const int s = (tid >> 4) + 32 * jj;
        float q[8], bb[8]; unpack8(c.q[jj], q);
        { const f32x4 a = *(const LAS f32x4*)(BF + s * 128 + 8 * cc), b = *(const LAS f32x4*)(BF + s * 128 + 8 * cc + 4); bb[0] = a.x; bb[1] = a.y; bb[2] = a.z; bb[3] = a.w; bb[4] = b.x; bb[5] = b.y; bb[6] = b.z; bb[7] = b.w; }
        float kt[8], qt[8], qh[8];
#pragma unroll
        for (int e = 0; e < 8; ++e) {
            const float E = fexp_(bm[e] - bb[e]);
            kt[e] = kreg[jj][e] * E;
            if (WANT_Q) { qt[e] = q[e] * rcpf_(E); qh[e] = q[e] * fexp_(bb[e]); }
        }
        *(LAS v4u*)(L + KT_OFF + offb(s, cc)) = (v4u){pk2(kt[0], kt[1]), pk2(kt[2], kt[3]), pk2(kt[4], kt[5]), pk2(kt[6], kt[7])};
        if (WANT_Q) {
            *(LAS v4u*)(L + QT_OFF + offb(s, cc)) = (v4u){pk2(qt[0], qt[1]), pk2(qt[2], qt[3]), pk2(qt[4], qt[5]), pk2(qt[6], qt[7])};
            *(LAS v4u*)(L + QH_OFF + offb(s, cc)) = (v4u){pk2(qh[0], qh[1]), pk2(qh[2], qh[3]), pk2(qh[4], qh[5]), pk2(qh[6], qh[7])};
        }
        *(LAS v4u*)(L + VT_OFF + offb(s, cc)) = c.v[jj];
    }
    WG_BARRIER();
}

__device__ __forceinline__ void pa_item(int it, int& h, int& nvalid, size_t& row0) {
    if (it < 16 * 127) { const int bh = it / 127, c = it % 127; h = bh & 3; row0 = (size_t)(bh >> 2) * SEQ + 64 * c; nvalid = 64; }
    else { h = it - 16 * 127; row0 = NTOK; nvalid = NMETA; }
}
__device__ __forceinline__ void pass_a(Frame& F) {
    const bf16* PROJ = (const bf16*)(F.ws + WS_PROJ); const float* LB = (const float*)(F.ws + WS_LB);
    bf16* DS = (bf16*)(F.ws + WS_DS); bf16* DSM = (bf16*)(F.ws + WS_DSM); float* DD = (float*)(F.ws + WS_DD);
    LAS unsigned char* L = F.lds; const int lane = F.lane, fr = lane & 15, fq = lane >> 4, w = F.wave;
    constexpr int NITEMS = 16 * 127 + 4;
    if (F.vcu >= NITEMS) return;
    Chunks ch; { int h, nv; size_t r0; pa_item(F.vcu, h, nv, r0); load_chunks<false>(ch, PROJ, r0, h, nv, F.tid); }
    for (int it = F.vcu; it < NITEMS; it += F.G) {
        int h, nvalid; size_t row0; pa_item(it, h, nvalid, row0);
        bf16* dst; float* ddst = nullptr;
        if (it < 16 * 127) { const int bh = it / 127, c = it % 127; dst = DS + (size_t)(bh * 128 + c) * 16384; ddst = DD + (size_t)(bh * 128 + c) * 128; } else dst = DSM + (size_t)h * 16384;
        prep<false>(F, ch, LB, h, nvalid);
        if (it + F.G < NITEMS) { int h2, nv2; size_t r2; pa_item(it + F.G, h2, nv2, r2); load_chunks<false>(ch, PROJ, r2, h2, nv2, F.tid); }
        f32x4 acc[8];
#pragma unroll
        for (int n = 0; n < 8; ++n) acc[n] = (f32x4){0.f, 0.f, 0.f, 0.f};
#pragma unroll
        for (int kk = 0; kk < 2; ++kk) {
            const bf16x8 a = trfrag(L + KT_OFF, lane, w, kk);
#pragma unroll
            for (int n = 0; n < 8; ++n) { const bf16x8 b = trfrag(L + VT_OFF, lane, n, kk); acc[n] = __builtin_amdgcn_mfma_f32_16x16x32_bf16(a, b, acc[n], 0, 0, 0); }
        }
        const LAS float* BMID = (const LAS float*)(L + BMID_OFF); const LAS float* BLAST = (const LAS float*)(L + BLAST_OFF);
        float sc[4];
#pragma unroll
        for (int j = 0; j < 4; ++j) { const int d = 16 * w + 4 * fq + j; sc[j] = fexp_(BLAST[d] - BMID[d]); }
#pragma unroll
        for (int n = 0; n < 8; ++n) { const int v = 16 * n + fr; *(v2u*)(dst + (size_t)v * 128 + 16 * w + 4 * fq) = (v2u){pk2(acc[n][0] * sc[0], acc[n][1] * sc[1]), pk2(acc[n][2] * sc[2], acc[n][3] * sc[3])}; }
        if (ddst && F.tid < 128) ddst[F.tid] = fexp_(BLAST[F.tid]);
        WG_BARRIER();
    }
}
__device__ __forceinline__ void scan_phase(Frame& F) {
    const bf16* DS = (const bf16*)(F.ws + WS_DS); const bf16* DSM = (const bf16*)(F.ws + WS_DSM); const float* DD = (const float*)(F.ws + WS_DD); bf16* SS = (bf16*)(F.ws + WS_SS);
    for (int t = F.vcu * NTHREADS + F.tid; t < 16 * 8192; t += F.G * NTHREADS) {
        const int bh = t >> 13, rem = t & 8191, v = rem >> 6, d = 2 * (rem & 63), h = bh & 3;
        const unsigned m = *(const unsigned*)(DSM + (size_t)h * 16384 + v * 128 + d);
        float s0 = bflo(m), s1 = bfhi(m);
        const size_t base = (size_t)bh * 128 * 16384 + (size_t)v * 128 + d;
        *(unsigned*)(SS + base) = m;
        const bf16* dsp = DS + base; const float* ddp = DD + (size_t)bh * 128 * 128 + d; bf16* ssp = SS + base + 16384;
        for (int c0 = 0; c0 < 127; c0 += 16) {
            unsigned ds[16]; f32x2 dd[16];
#pragma unroll
            for (int i = 0; i < 16; ++i) { const int c = (c0 + i < 127) ? c0 + i : 126; ds[i] = *(const unsigned*)(dsp + (size_t)c * 16384); dd[i] = *(const f32x2*)(ddp + (size_t)c * 128); }
#pragma unroll
            for (int i = 0; i < 16; ++i) if (c0 + i < 127) { s0 = dd[i].x * s0 + bflo(ds[i]); s1 = dd[i].y * s1 + bfhi(ds[i]); *(unsigned*)(ssp + (size_t)(c0 + i) * 16384) = pk2(s0, s1); }
        }
    }
}
__device__ __forceinline__ void pass_c(Frame& F) {
    const bf16* PROJ = (const bf16*)(F.ws + WS_PROJ); const float* LB = (const float*)(F.ws + WS_LB); const bf16* SS = (const bf16*)(F.ws + WS_SS); bf16* Y = (bf16*)(F.ws + WS_Y);
    const float* hg_ = F.in[5]; const float* cw = F.in[6]; const float* cg = F.in[7];
    LAS unsigned char* L = F.lds; const int tid = F.tid, lane = F.lane, fr = lane & 15, fq = lane >> 4, w = F.wave, cc = tid & 15;
    constexpr int NITEMS = 16 * 128;
    if (F.vcu >= NITEMS) return;
    Chunks ch; v4u st[4];
    { const int it = F.vcu, bh = it >> 7, c = it & 127; load_chunks<true>(ch, PROJ, (size_t)(bh >> 2) * SEQ + 64 * c, bh & 3, 64, tid);
      const bf16* sp = SS + (size_t)it * 16384;
#pragma unroll
      for (int i = 0; i < 4; ++i) st[i] = *(const v4u*)(sp + (size_t)(tid + 512 * i) * 8); }
    for (int it = F.vcu; it < NITEMS; it += F.G) {
        const int bh = it >> 7, c = it & 127, b = bh >> 2, h = bh & 3; const size_t row0 = (size_t)b * SEQ + 64 * c;
        prep<true>(F, ch, LB, h, 64);
#pragma unroll
        for (int i = 0; i < 4; ++i) { const int ci = tid + 512 * i; *(LAS v4u*)(L + BF_OFF + offb(ci >> 4, ci & 15)) = st[i]; }
        if (it + F.G < NITEMS) { const int it2 = it + F.G, bh2 = it2 >> 7, c2 = it2 & 127; load_chunks<true>(ch, PROJ, (size_t)(bh2 >> 2) * SEQ + 64 * c2, bh2 & 3, 64, tid);
            const bf16* sp = SS + (size_t)it2 * 16384;
#pragma unroll
            for (int i = 0; i < 4; ++i) st[i] = *(const v4u*)(sp + (size_t)(tid + 512 * i) * 8); }
        v4u eg[2], eb[2], ec0[2], ev0[2], ec1[2], ev1[2], ec2[2], ev2[2];
#pragma unroll
        for (int jj = 0; jj < 2; ++jj) {
            const int s = (tid >> 4) + 32 * jj, t = 64 * c + s; const bf16* pr = PROJ + (row0 + s) * PW + h * 128 + 8 * cc;
            const bf16* p1 = (t >= 1) ? pr - PW : PROJ + (size_t)(NTOK + 15) * PW + h * 128 + 8 * cc;
            const bf16* p2 = (t >= 2) ? pr - 2 * PW : PROJ + (size_t)(NTOK + 14 + t) * PW + h * 128 + 8 * cc;
            eg[jj] = *(const v4u*)(pr + 1536); eb[jj] = *(const v4u*)(pr + 2048); ec0[jj] = *(const v4u*)(pr + 2560); ev0[jj] = *(const v4u*)(pr + 3072);
            ec1[jj] = *(const v4u*)(p1 + 2560); ev1[jj] = *(const v4u*)(p1 + 3072); ec2[jj] = *(const v4u*)(p2 + 2560); ev2[jj] = *(const v4u*)(p2 + 3072);
        }
        {
            const int ti = w & 3; f32x4 sa[2] = {(f32x4){0.f, 0.f, 0.f, 0.f}, (f32x4){0.f, 0.f, 0.f, 0.f}};
#pragma unroll
            for (int kk = 0; kk < 4; ++kk) {
                const bf16x8 a = rowfrag(L + QT_OFF, lane, ti, kk);
#pragma unroll
                for (int x = 0; x < 2; ++x) { const bf16x8 bb = rowfrag(L + KT_OFF, lane, 2 * (w >> 2) + x, kk); sa[x] = __builtin_amdgcn_mfma_f32_16x16x32_bf16(a, bb, sa[x], 0, 0, 0); }
            }
#pragma unroll
            for (int x = 0; x < 2; ++x) { const int s = 16 * (2 * (w >> 2) + x) + fr;
#pragma unroll
                for (int j = 0; j < 4; ++j) { const int t = 16 * ti + 4 * fq + j; const float pv = (t >= s) ? sa[x][j] : 0.f; *(LAS bf16*)(L + PP_OFF + off8(t, s >> 3) + 2 * (s & 7)) = (bf16)f2bf(pv); } }
        }
        WG_BARRIER();
        {
            const int ti = w & 3; f32x4 oa[4];
#pragma unroll
            for (int n = 0; n < 4; ++n) oa[n] = (f32x4){0.f, 0.f, 0.f, 0.f};
#pragma unroll
            for (int kk = 0; kk < 2; ++kk) {
                const bf16x8 a = *(const LAS bf16x8*)(L + PP_OFF + off8(16 * ti + fr, 4 * kk + fq));
#pragma unroll
                for (int n = 0; n < 4; ++n) { const bf16x8 bb = trfrag(L + VT_OFF, lane, 4 * (w >> 2) + n, kk); oa[n] = __builtin_amdgcn_mfma_f32_16x16x32_bf16(a, bb, oa[n], 0, 0, 0); }
            }
#pragma unroll
            for (int kk = 0; kk < 4; ++kk) {
                const bf16x8 a = rowfrag(L + QH_OFF, lane, ti, kk);
#pragma unroll
                for (int n = 0; n < 4; ++n) { const bf16x8 bb = rowfrag(L + BF_OFF, lane, 4 * (w >> 2) + n, kk); oa[n] = __builtin_amdgcn_mfma_f32_16x16x32_bf16(a, bb, oa[n], 0, 0, 0); }
            }
            LAS float* OI = (LAS float*)(L + OI_OFF);
#pragma unroll
            for (int n = 0; n < 4; ++n) { const int v = 16 * (4 * (w >> 2) + n) + fr;
#pragma unroll
                for (int j = 0; j < 4; ++j) { const int t = 16 * ti + 4 * fq + j; OI[t * 128 + (v ^ (((t >> 2) & 1) << 4))] = oa[n][j]; } }
        }
        WG_BARRIER();
        {
            const LAS float* OI = (const LAS float*)(L + OI_OFF);
            float hgn[8], cgn[8], w0[8], w1[8], w2[8];
            { const int c8 = h * 128 + 8 * cc;
              const f32x4 a = *(const f32x4*)(hg_ + c8), b2 = *(const f32x4*)(hg_ + c8 + 4), c4 = *(const f32x4*)(cg + c8), d4 = *(const f32x4*)(cg + c8 + 4);
              const f32x4 k0a = *(const f32x4*)(cw + c8), k0b = *(const f32x4*)(cw + c8 + 4), k1a = *(const f32x4*)(cw + HW + c8), k1b = *(const f32x4*)(cw + HW + c8 + 4), k2a = *(const f32x4*)(cw + 2 * HW + c8), k2b = *(const f32x4*)(cw + 2 * HW + c8 + 4);
#pragma unroll
              for (int e = 0; e < 4; ++e) { hgn[e] = a[e]; hgn[4 + e] = b2[e]; cgn[e] = c4[e]; cgn[4 + e] = d4[e]; w0[e] = k0a[e]; w0[4 + e] = k0b[e]; w1[e] = k1a[e]; w1[4 + e] = k1b[e]; w2[e] = k2a[e]; w2[4 + e] = k2b[e]; } }
#pragma unroll
            for (int jj = 0; jj < 2; ++jj) {
                const int s = (tid >> 4) + 32 * jj; const size_t row = row0 + s;
                const int vo = (8 * cc) ^ (((s >> 2) & 1) << 4);
                const f32x4 oa4 = *(const LAS f32x4*)(OI + s * 128 + vo), ob4 = *(const LAS f32x4*)(OI + s * 128 + vo + 4);
                float o[8] = {oa4[0], oa4[1], oa4[2], oa4[3], ob4[0], ob4[1], ob4[2], ob4[3]};
                float ss = 0.f;
#pragma unroll
                for (int e = 0; e < 8; ++e) ss += o[e] * o[e];
                ss += __shfl_xor(ss, 1); ss += __shfl_xor(ss, 2); ss += __shfl_xor(ss, 4); ss += __shfl_xor(ss, 8);
                const float rs = rsqf_(ss * (1.f / 128.f) + EPS);
                float g[8]; unpack8(eg[jj], g);
                float yh[8];
#pragma unroll
                for (int e = 0; e < 8; ++e) yh[e] = o[e] * rs * hgn[e] * siluf_(g[e]);
                *(v4u*)(Y + row * D + h * 128 + 8 * cc) = (v4u){pk2(yh[0], yh[1]), pk2(yh[2], yh[3]), pk2(yh[4], yh[5]), pk2(yh[6], yh[7])};
                float bg[8], c0f[8], v0f[8], c1f[8], v1f[8], c2f[8], v2f[8];
                unpack8(eb[jj], bg); unpack8(ec0[jj], c0f); unpack8(ev0[jj], v0f); unpack8(ec1[jj], c1f); unpack8(ev1[jj], v1f); unpack8(ec2[jj], c2f); unpack8(ev2[jj], v2f);
                float yc[8]; float s2 = 0.f;
#pragma unroll
                for (int e = 0; e < 8; ++e) { const float cv = w0[e] * (c2f[e] * v2f[e]) + w1[e] * (c1f[e] * v1f[e]) + w2[e] * (c0f[e] * v0f[e]); yc[e] = bg[e] * cv; s2 += yc[e] * yc[e]; }
                s2 += __shfl_xor(s2, 1); s2 += __shfl_xor(s2, 2); s2 += __shfl_xor(s2, 4); s2 += __shfl_xor(s2, 8);
                const float rc = rsqf_(s2 * (1.f / 128.f) + EPS);
#pragma unroll
                for (int e = 0; e < 8; ++e) yc[e] = yc[e] * rc * cgn[e];
                *(v4u*)(Y + row * D + HW + h * 128 + 8 * cc) = (v4u){pk2(yc[0], yc[1]), pk2(yc[2], yc[3]), pk2(yc[4], yc[5]), pk2(yc[6], yc[7])};
            }
        }
    }
    WG_BARRIER();
}
constexpr int SEG_CH = 8, NSEG = 16;
__device__ __forceinline__ void seg_step(int bh, int seg, int k, int& h, int& nvalid, size_t& row0, int& chunk) {
    h = bh & 3;
    if (seg == 0) { if (k == 0) { row0 = NTOK; nvalid = NMETA; chunk = -1; return; } chunk = k - 1; }
    else chunk = seg * SEG_CH + k;
    row0 = (size_t)(bh >> 2) * SEQ + 64 * chunk; nvalid = 64;
}
template <bool LOGD>
__device__ __forceinline__ void state_step(LAS unsigned char* L, int lane, int w, f32x4 (&S)[8], float (&logd)[4]) {
    const int fq = lane >> 4;
    const LAS float* BMID = (const LAS float*)(L + BMID_OFF); const LAS float* BLAST = (const LAS float*)(L + BLAST_OFF);
    float sc[4], dc[4];
#pragma unroll
    for (int j = 0; j < 4; ++j) { const int d = 16 * w + 4 * fq + j; const float bl = BLAST[d]; sc[j] = fexp_(bl - BMID[d]); dc[j] = fexp_(bl); if (LOGD) logd[j] += bl; }
    const bf16x8 a0 = trfrag(L + KT_OFF, lane, w, 0), a1 = trfrag(L + KT_OFF, lane, w, 1);
#pragma unroll
    for (int hf = 0; hf < 2; ++hf) {
        f32x4 acc[4];
#pragma unroll
        for (int n = 0; n < 4; ++n) { acc[n] = (f32x4){0.f, 0.f, 0.f, 0.f};
            acc[n] = __builtin_amdgcn_mfma_f32_16x16x32_bf16(a0, trfrag(L + VT_OFF, lane, 4 * hf + n, 0), acc[n], 0, 0, 0);
            acc[n] = __builtin_amdgcn_mfma_f32_16x16x32_bf16(a1, trfrag(L + VT_OFF, lane, 4 * hf + n, 1), acc[n], 0, 0, 0); }
#pragma unroll
        for (int n = 0; n < 4; ++n)
#pragma unroll
            for (int j = 0; j < 4; ++j) S[4 * hf + n][j] = S[4 * hf + n][j] * dc[j] + acc[n][j] * sc[j];
    }
}
__device__ __forceinline__ void pass_a2(Frame& F) {
    const bf16* PROJ = (const bf16*)(F.ws + WS_PROJ); const float* LB = (const float*)(F.ws + WS_LB);
    float* DSEG = (float*)(F.ws + WS_SS); float* DDSEG = (float*)(F.ws + WS_DD);
    LAS unsigned char* L = F.lds; const int lane = F.lane, fr = lane & 15, fq = lane >> 4, w = F.wave;
    for (int it = F.vcu; it < 16 * NSEG; it += F.G) {
        const int bh = it >> 4, seg = it & 15, nsteps = SEG_CH + (seg == 0 ? 1 : 0);
        f32x4 S[8]; float logd[4] = {0.f, 0.f, 0.f, 0.f};
#pragma unroll
        for (int n = 0; n < 8; ++n) S[n] = (f32x4){0.f, 0.f, 0.f, 0.f};
        Chunks ch; { int h, nv, c; size_t r0; seg_step(bh, seg, 0, h, nv, r0, c); load_chunks<false>(ch, PROJ, r0, h, nv, F.tid); }
        for (int k = 0; k < nsteps; ++k) {
            int h, nvalid, c; size_t row0; seg_step(bh, seg, k, h, nvalid, row0, c);
            prep<false>(F, ch, LB, h, nvalid);
            if (k + 1 < nsteps) { int h2, nv2, c2; size_t r2; seg_step(bh, seg, k + 1, h2, nv2, r2, c2); load_chunks<false>(ch, PROJ, r2, h2, nv2, F.tid); }
            state_step<true>(L, lane, w, S, logd);
            if (seg == 0 && k == 0 && bh < 4) {
                float* sm = (float*)(F.ws + WS_DSM) + (size_t)bh * 16384;
#pragma unroll
                for (int n = 0; n < 8; ++n) *(f32x4*)(sm + (size_t)(16 * n + fr) * 128 + 16 * w + 4 * fq) = S[n];
            }
            WG_BARRIER();
        }
        float* dst = DSEG + (size_t)it * 16384;
#pragma unroll
        for (int n = 0; n < 8; ++n) *(f32x4*)(dst + (size_t)(16 * n + fr) * 128 + 16 * w + 4 * fq) = S[n];
        if (fr == 0) *(f32x4*)(DDSEG + (size_t)it * 128 + 16 * w + 4 * fq) = (f32x4){fexp_(logd[0]), fexp_(logd[1]), fexp_(logd[2]), fexp_(logd[3])};
    }
}
__device__ __forceinline__ void pass_c2(Frame& F) {
    const bf16* PROJ = (const bf16*)(F.ws + WS_PROJ); const float* LB = (const float*)(F.ws + WS_LB); bf16* Y = (bf16*)(F.ws + WS_Y);
    const float* DSEG = (const float*)(F.ws + WS_SS); const float* DDSEG = (const float*)(F.ws + WS_DD);
    const float* hg_ = F.in[5]; const float* cw = F.in[6]; const float* cg = F.in[7];
    LAS unsigned char* L = F.lds; const int w = F.wave;
    for (int it = F.vcu; it < 16 * NSEG; it += F.G) {
        const int bh = it >> 4, seg = it & 15, b = bh >> 2, h = bh & 3, nsteps = SEG_CH;
        int tid0 = F.tid; asm volatile("" : "+v"(tid0)); int lane0 = tid0 & 63;
        if (tid0 < 128) { LAS float* CT = (LAS float*)(L + CONST_OFF); const int c8 = h * 128 + tid0; CT[tid0] = hg_[c8]; CT[128 + tid0] = cg[c8]; CT[256 + tid0] = cw[c8]; CT[384 + tid0] = cw[HW + c8]; CT[512 + tid0] = cw[2 * HW + c8]; }
        Chunks ch; { int h0, nv, c; size_t r0; seg_step(bh, seg, seg == 0 ? 1 : 0, h0, nv, r0, c); load_chunks<true, false, true>(ch, PROJ, r0, h0, nv, tid0); }
        f32x4 S[8]; float logd[4] = {0.f, 0.f, 0.f, 0.f};
#pragma unroll
        for (int n = 0; n < 8; ++n) S[n] = (f32x4){0.f, 0.f, 0.f, 0.f};
        { const int fr = lane0 & 15, fq = lane0 >> 4;
        if (seg == 0) { const float* sm = (const float*)(F.ws + WS_DSM) + (size_t)h * 16384;
#pragma unroll
            for (int n = 0; n < 8; ++n) S[n] = *(const f32x4*)(sm + (size_t)(16 * n + fr) * 128 + 16 * w + 4 * fq); }
        for (int g = 0; g < seg; ++g) {
            const float* src = DSEG + (size_t)(bh * NSEG + g) * 16384; const f32x4 dg = *(const f32x4*)(DDSEG + (size_t)(bh * NSEG + g) * 128 + 16 * w + 4 * fq);
#pragma unroll
            for (int n = 0; n < 8; ++n) { const f32x4 ds = *(const f32x4*)(src + (size_t)(16 * n + fr) * 128 + 16 * w + 4 * fq); S[n] = S[n] * dg + ds; }
        } }
        for (int k = 0; k < nsteps; ++k) {
            int hh, nvalid, c; size_t row0; seg_step(bh, seg, k + (seg == 0 ? 1 : 0), hh, nvalid, row0, c);
            int tl = tid0; asm volatile("" : "+v"(tl)); const int tid = tl, cc = tl & 15, ln = tl & 63, fr = ln & 15, fq = ln >> 4;
            if (c < 0) {
                prep<false>(F, ch, LB, h, nvalid, tid);
                { int h2, nv2, c2; size_t r2; seg_step(bh, seg, k + 1, h2, nv2, r2, c2); load_chunks<true, false, true>(ch, PROJ, r2, h2, nv2, tid); }
                state_step<false>(L, ln, w, S, logd);
                WG_BARRIER();
                continue;
            }
            { const char* base = (const char*)PROJ;
#pragma unroll
              for (int jj = 0; jj < 2; ++jj) { const int s = (tid >> 4) + 32 * jj; ch.v[jj] = __builtin_nontemporal_load((const v4u*)(base + (unsigned)(((unsigned)row0 + (unsigned)s) * (unsigned)PW + (unsigned)(h * 128 + 8 * cc)) * 2u + 2048)); } }
            prep<true>(F, ch, LB, h, 64, tid);
#pragma unroll
            for (int n = 0; n < 8; ++n) { const int v = 16 * n + fr, d = 16 * w + 4 * fq; *(LAS v2u*)(L + BF_OFF + offb(v, d >> 3) + 2 * (d & 7)) = (v2u){pk2(S[n][0], S[n][1]), pk2(S[n][2], S[n][3])}; }
            v4u eg[2], eb[2], ec0[2], ev0[2], ec1[2], ev1[2], ec2[2], ev2[2];
#define HG_EPI_LOAD(jj) do { const int s = (tid >> 4) + 32 * (jj), t = 64 * c + s; const char* pb = (const char*)PROJ; const unsigned col = (unsigned)(h * 128 + 8 * cc) * 2u; \
                const unsigned o0 = ((unsigned)row0 + (unsigned)s) * (unsigned)(PW * 2) + col; \
                const unsigned o1 = (t >= 1) ? o0 - (unsigned)(PW * 2) : (unsigned)(NTOK + 15) * (unsigned)(PW * 2) + col; \
                const unsigned o2 = (t >= 2) ? o0 - (unsigned)(PW * 4) : (unsigned)(NTOK + 14 + t) * (unsigned)(PW * 2) + col; \
                eg[jj] = __builtin_nontemporal_load((const v4u*)(pb + o0 + 3072)); eb[jj] = __builtin_nontemporal_load((const v4u*)(pb + o0 + 4096)); ec0[jj] = *(const v4u*)(pb + o0 + 5120); ev0[jj] = *(const v4u*)(pb + o0 + 6144); \
                ec1[jj] = *(const v4u*)(pb + o1 + 5120); ev1[jj] = *(const v4u*)(pb + o1 + 6144); ec2[jj] = *(const v4u*)(pb + o2 + 5120); ev2[jj] = *(const v4u*)(pb + o2 + 6144); } while (0)
            HG_EPI_LOAD(0);
            {
                const int ti = w & 3; f32x4 sa[2] = {(f32x4){0.f, 0.f, 0.f, 0.f}, (f32x4){0.f, 0.f, 0.f, 0.f}};
#pragma unroll
                for (int kk = 0; kk < 4; ++kk) {
                    const bf16x8 a = rowfrag(L + QT_OFF, ln, ti, kk);
#pragma unroll
                    for (int x = 0; x < 2; ++x) { const bf16x8 bb = rowfrag(L + KT_OFF, ln, 2 * (w >> 2) + x, kk); sa[x] = __builtin_amdgcn_mfma_f32_16x16x32_bf16(a, bb, sa[x], 0, 0, 0); }
                }
#pragma unroll
                for (int x = 0; x < 2; ++x) { const int s = 16 * (2 * (w >> 2) + x) + fr;
#pragma unroll
                    for (int j = 0; j < 4; ++j) { const int t = 16 * ti + 4 * fq + j; const float pv = (t >= s) ? sa[x][j] : 0.f; *(LAS bf16*)(L + PP_OFF + off8(t, s >> 3) + 2 * (s & 7)) = (bf16)f2bf(pv); } }
            }
            WG_BARRIER();
            state_step<false>(L, ln, w, S, logd);
            if (k + 1 < nsteps) { int h2, nv2, c2; size_t r2; seg_step(bh, seg, k + 1 + (seg == 0 ? 1 : 0), h2, nv2, r2, c2); load_chunks<true, false, true>(ch, PROJ, r2, h2, nv2, tid); }
            HG_EPI_LOAD(1);
            {
                const int ti = w & 3; f32x4 oa[4];
#pragma unroll
                for (int n = 0; n < 4; ++n) oa[n] = (f32x4){0.f, 0.f, 0.f, 0.f};
#pragma unroll
                for (int kk = 0; kk < 2; ++kk) {
                    const bf16x8 a = *(const LAS bf16x8*)(L + PP_OFF + off8(16 * ti + fr, 4 * kk + fq));
#pragma unroll
                    for (int n = 0; n < 4; ++n) { const bf16x8 bb = trfrag(L + VT_OFF, ln, 4 * (w >> 2) + n, kk); oa[n] = __builtin_amdgcn_mfma_f32_16x16x32_bf16(a, bb, oa[n], 0, 0, 0); }
                }
#pragma unroll
                for (int kk = 0; kk < 4; ++kk) {
                    const bf16x8 a = rowfrag(L + QH_OFF, ln, ti, kk);
#pragma unroll
                    for (int n = 0; n < 4; ++n) { const bf16x8 bb = rowfrag(L + BF_OFF, ln, 4 * (w >> 2) + n, kk); oa[n] = __builtin_amdgcn_mfma_f32_16x16x32_bf16(a, bb, oa[n], 0, 0, 0); }
                }
#pragma unroll
                for (int n = 0; n < 4; ++n) { const int v = 16 * (4 * (w >> 2) + n) + fr;
#pragma unroll
                    for (int j = 0; j < 4; ++j) { const int t = 16 * ti + 4 * fq + j; *(LAS bf16*)(L + QT_OFF + offb(t, v >> 3) + 2 * (v & 7)) = (bf16)f2bf(oa[n][j]); } }
            }
#undef HG_EPI_LOAD
            WG_BARRIER();
            {
                const LAS float* CT = (const LAS float*)(L + CONST_OFF);
#pragma unroll
                for (int jj = 0; jj < 2; ++jj) {
                    const int s = (tid >> 4) + 32 * jj; const unsigned yo = (((unsigned)row0 + (unsigned)s) * (unsigned)D + (unsigned)(h * 128 + 8 * cc)) * 2u;
                    const v4u ow = *(const LAS v4u*)(L + QT_OFF + offb(s, cc)); float o[8]; unpack8(ow, o);
                    float ss = 0.f;
#pragma unroll
                    for (int e = 0; e < 8; ++e) ss += o[e] * o[e];
                    ss += __shfl_xor(ss, 1); ss += __shfl_xor(ss, 2); ss += __shfl_xor(ss, 4); ss += __shfl_xor(ss, 8);
                    const float rs = rsqf_(ss * (1.f / 128.f) + EPS);
                    float g[8]; unpack8(eg[jj], g);
                    const f32x4 ha = *(const LAS f32x4*)(CT + 8 * cc), hb = *(const LAS f32x4*)(CT + 8 * cc + 4);
                    float yh[8];
#pragma unroll
                    for (int e = 0; e < 8; ++e) yh[e] = o[e] * rs * (e < 4 ? ha[e] : hb[e - 4]) * siluf_(g[e]);
                    *(v4u*)((char*)Y + yo) = (v4u){pk2(yh[0], yh[1]), pk2(yh[2], yh[3]), pk2(yh[4], yh[5]), pk2(yh[6], yh[7])};
                }
#pragma unroll
                for (int jj = 0; jj < 2; ++jj) {
                    const int s = (tid >> 4) + 32 * jj; const unsigned yo = (((unsigned)row0 + (unsigned)s) * (unsigned)D + (unsigned)(h * 128 + 8 * cc)) * 2u;
                    float cf[8], vf[8], cv[8];
                    unpack8(ec2[jj], cf); unpack8(ev2[jj], vf);
                    { const f32x4 wa = *(const LAS f32x4*)(CT + 256 + 8 * cc), wb = *(const LAS f32x4*)(CT + 256 + 8 * cc + 4);
#pragma unroll
                      for (int e = 0; e < 8; ++e) cv[e] = (e < 4 ? wa[e] : wb[e - 4]) * (cf[e] * vf[e]); }
                    unpack8(ec1[jj], cf); unpack8(ev1[jj], vf);
                    { const f32x4 wa = *(const LAS f32x4*)(CT + 384 + 8 * cc), wb = *(const LAS f32x4*)(CT + 384 + 8 * cc + 4);
#pragma unroll
                      for (int e = 0; e < 8; ++e) cv[e] += (e < 4 ? wa[e] : wb[e - 4]) * (cf[e] * vf[e]); }
                    unpack8(ec0[jj], cf); unpack8(ev0[jj], vf);
                    { const f32x4 wa = *(const LAS f32x4*)(CT + 512 + 8 * cc), wb = *(const LAS f32x4*)(CT + 512 + 8 * cc + 4);
#pragma unroll
                      for (int e = 0; e < 8; ++e) cv[e] += (e < 4 ? wa[e] : wb[e - 4]) * (cf[e] * vf[e]); }
                    unpack8(eb[jj], cf);
                    float s2 = 0.f;
#pragma unroll
                    for (int e = 0; e < 8; ++e) { cv[e] *= cf[e]; s2 += cv[e] * cv[e]; }
                    s2 += __shfl_xor(s2, 1); s2 += __shfl_xor(s2, 2); s2 += __shfl_xor(s2, 4); s2 += __shfl_xor(s2, 8);
                    const float rc = rsqf_(s2 * (1.f / 128.f) + EPS);
                    const f32x4 ga = *(const LAS f32x4*)(CT + 128 + 8 * cc), gb = *(const LAS f32x4*)(CT + 128 + 8 * cc + 4);
#pragma unroll
                    for (int e = 0; e < 8; ++e) cv[e] = cv[e] * rc * (e < 4 ? ga[e] : gb[e - 4]);
                    *(v4u*)((char*)Y + yo + 1024) = (v4u){pk2(cv[0], cv[1]), pk2(cv[2], cv[3]), pk2(cv[4], cv[5]), pk2(cv[6], cv[7])};
                }
            }
        }
        WG_BARRIER();
    }
}
}

__device__ __forceinline__ void post_phase(Frame& F) {
    const bf16* PROJ = (const bf16*)(F.ws + WS_PROJ); const float* ORAW = (const float*)(F.ws + WS_ORAW); bf16* Y = (bf16*)(F.ws + WS_Y);
    const float* hg = F.in[5]; const float* cw = F.in[6]; const float* cg = F.in[7];
    const int gw = F.vcu * NWAVES + F.wave, NGW = F.G * NWAVES, lane = F.lane, c0 = 8 * lane;
    for (int row = gw; row < NTOK; row += NGW) {
        const int t = row & (SEQ - 1);
        const bf16* pr = PROJ + (size_t)row * PW;
        float o[8]; { const f32x4 a = *(const f32x4*)(ORAW + (size_t)row * HW + c0), b2 = *(const f32x4*)(ORAW + (size_t)row * HW + c0 + 4);
            o[0] = a.x; o[1] = a.y; o[2] = a.z; o[3] = a.w; o[4] = b2.x; o[5] = b2.y; o[6] = b2.z; o[7] = b2.w; }
        float ss = 0.f;
#pragma unroll
        for (int j = 0; j < 8; ++j) ss += o[j] * o[j];
        ss += __shfl_xor(ss, 1); ss += __shfl_xor(ss, 2); ss += __shfl_xor(ss, 4); ss += __shfl_xor(ss, 8);
        const float rs = rsqf_(ss * (1.f / 128.f) + EPS);
        const v4u gq = *(const v4u*)(pr + 1536 + c0);
        float gv[8] = {bflo(gq.x), bfhi(gq.x), bflo(gq.y), bfhi(gq.y), bflo(gq.z), bfhi(gq.z), bflo(gq.w), bfhi(gq.w)};
        float yh[8];
#pragma unroll
        for (int j = 0; j < 8; ++j) yh[j] = o[j] * rs * hg[c0 + j] * siluf_(gv[j]);
        v4u oh; oh.x = pk2(yh[0], yh[1]); oh.y = pk2(yh[2], yh[3]); oh.z = pk2(yh[4], yh[5]); oh.w = pk2(yh[6], yh[7]);
        *(v4u*)(Y + (size_t)row * D + c0) = oh;
        const bf16* p1 = (t >= 1) ? pr - PW : PROJ + (size_t)(NTOK + 15) * PW;
        const bf16* p2 = (t >= 2) ? pr - 2 * PW : PROJ + (size_t)(NTOK + 14 + t) * PW;
        float u0[8], u1[8], u2[8], bg[8];
        { const v4u c = *(const v4u*)(pr + 2560 + c0), v = *(const v4u*)(pr + 3072 + c0), bq = *(const v4u*)(pr + 2048 + c0);
          const unsigned cc[4] = {c.x, c.y, c.z, c.w}, vv[4] = {v.x, v.y, v.z, v.w}, bb[4] = {bq.x, bq.y, bq.z, bq.w};
#pragma unroll
          for (int j = 0; j < 4; ++j) { u0[2 * j] = bflo(cc[j]) * bflo(vv[j]); u0[2 * j + 1] = bfhi(cc[j]) * bfhi(vv[j]); bg[2 * j] = bflo(bb[j]); bg[2 * j + 1] = bfhi(bb[j]); } }
        { const v4u c = *(const v4u*)(p1 + 2560 + c0), v = *(const v4u*)(p1 + 3072 + c0); const unsigned cc[4] = {c.x, c.y, c.z, c.w}, vv[4] = {v.x, v.y, v.z, v.w};
#pragma unroll
          for (int j = 0; j < 4; ++j) { u1[2 * j] = bflo(cc[j]) * bflo(vv[j]); u1[2 * j + 1] = bfhi(cc[j]) * bfhi(vv[j]); } }
        { const v4u c = *(const v4u*)(p2 + 2560 + c0), v = *(const v4u*)(p2 + 3072 + c0); const unsigned cc[4] = {c.x, c.y, c.z, c.w}, vv[4] = {v.x, v.y, v.z, v.w};
#pragma unroll
          for (int j = 0; j < 4; ++j) { u2[2 * j] = bflo(cc[j]) * bflo(vv[j]); u2[2 * j + 1] = bfhi(cc[j]) * bfhi(vv[j]); } }
        float yc[8]; float s2 = 0.f;
#pragma unroll
        for (int j = 0; j < 8; ++j) { const float cv = cw[c0 + j] * u2[j] + cw[HW + c0 + j] * u1[j] + cw[2 * HW + c0 + j] * u0[j]; yc[j] = bg[j] * cv; s2 += yc[j] * yc[j]; }
        s2 += __shfl_xor(s2, 1); s2 += __shfl_xor(s2, 2); s2 += __shfl_xor(s2, 4); s2 += __shfl_xor(s2, 8);
        const float rc = rsqf_(s2 * (1.f / 128.f) + EPS);
#pragma unroll
        for (int j = 0; j < 8; ++j) yc[j] = yc[j] * rc * cg[c0 + j];
        v4u oc; oc.x = pk2(yc[0], yc[1]); oc.y = pk2(yc[2], yc[3]); oc.z = pk2(yc[4], yc[5]); oc.w = pk2(yc[6], yc[7]);
        *(v4u*)(Y + (size_t)row * D + HW + c0) = oc;
    }
}

__device__ __forceinline__ void router_phase(Frame& F) {
    const bf16* H1 = (const bf16*)(F.ws + WS_H1); const bf16* WrT = (const bf16*)(F.ws + WS_WR); const float* sumsq = (const float*)(F.ws + WS_SUMSQ);
    int* tokl = (int*)(F.ws + WS_TOK); f32x2* scl = (f32x2*)(F.ws + WS_SCL); f32x2* scls = (f32x2*)(F.ws + WS_SCLS); int* slot = (int*)(F.ws + WS_SLOT);
    unsigned* counts = (unsigned*)(F.ws + WS_CTL) + CW_CNT; const float* rbias = F.in[11];
    const int lane = F.lane, fr = lane & 15, fq = lane >> 4, w = F.wave, tid = F.tid;
    LAS float* sc = (LAS float*)F.lds + w * 2048;
    LAS float* kb = sc + 1024;
    LAS int* hist = (LAS int*)(F.lds + 65536);
    LAS int* base = hist + 64;
    LAS int* sel_e = base + 64;
    LAS int* sel_r = sel_e + 1024;
    LAS float* sel_g = (LAS float*)(sel_r + 1024);
    LAS float* sel_rs = sel_g + 1024;
    float bias4[4];
#pragma unroll
    for (int n = 0; n < 4; ++n) bias4[n] = rbias[16 * n + fr];
    for (int blk = F.vcu; blk < NTOK / 128; blk += F.G) {
        if (tid < 64) hist[tid] = 0;
        __syncthreads();
        const int tok0 = blk * 128 + w * 16;
        f32x4 acc[4];
#pragma unroll
        for (int n = 0; n < 4; ++n) acc[n] = (f32x4){0.f, 0.f, 0.f, 0.f};
        const char* ap = (const char*)(H1 + (size_t)(tok0 + fr) * D + 8 * fq);
#define RT_STAGE(q) do { _Pragma("unroll") for (int i = 0; i < 4; ++i) { const int pp = (w * 4 + i) * 64 + lane, row = pp >> 5, lc = (pp & 31) ^ (row & 15); \
            __builtin_amdgcn_global_load_lds((const unsigned*)((const char*)WrT + (size_t)row * (D * 2) + (q) * 512 + lc * 16), (LAS unsigned*)(F.lds + ((q) & 1) * 32768 + (w * 4 + i) * 1024), 16, 0, 0); } } while (0)
        bf16x8 a0[8], a1[8];
        RT_STAGE(0);
#pragma unroll
        for (int ks = 0; ks < 8; ++ks) a0[ks] = *(const bf16x8*)(ap + ks * 64);
#pragma unroll
        for (int q = 0; q < 4; ++q) {
            asm volatile("s_waitcnt vmcnt(0)" ::: "memory");
            WG_BARRIER();
            if (q + 1 < 4) { RT_STAGE(q + 1);
#pragma unroll
                for (int ks = 0; ks < 8; ++ks) { if (q & 1) a0[ks] = *(const bf16x8*)(ap + (q + 1) * 512 + ks * 64); else a1[ks] = *(const bf16x8*)(ap + (q + 1) * 512 + ks * 64); } }
            const LAS unsigned char* Bq = F.lds + (q & 1) * 32768;
#pragma unroll
            for (int ks = 0; ks < 8; ++ks)
#pragma unroll
                for (int n = 0; n < 4; ++n) { const int row = 16 * n + fr; const bf16x8 b = *(const LAS bf16x8*)(Bq + row * 512 + (((4 * ks + fq) ^ (row & 15)) << 4));
                    acc[n] = __builtin_amdgcn_mfma_f32_16x16x32_bf16((q & 1) ? a1[ks] : a0[ks], b, acc[n], 0, 0, 0); }
        }
#undef RT_STAGE
        WG_BARRIER();
#pragma unroll
        for (int j = 0; j < 4; ++j) { const int r = 4 * fq + j; const float rs = rsqf_(sumsq[tok0 + r] * (1.f / D) + EPS);
#pragma unroll
            for (int n = 0; n < 4; ++n) { const int e = 16 * n + fr; const float s = sigmoidf_(acc[n][j] * rs); sc[r * 64 + e] = s;
                kb[r * 64 + e] = __builtin_bit_cast(float, (__builtin_bit_cast(unsigned, s + bias4[n]) & ~63u) | (unsigned)(63 - e)); }
            if (fr == 0) { sel_rs[w * 16 + r] = rs; scls[tok0 + r] = (f32x2){rs, rs}; } }
        LDS_WAIT(); asm volatile("" ::: "memory");
#pragma unroll 2
        for (int r = 0; r < 16; ++r) {
            const float my = kb[r * 64 + lane]; int rank = 0;
#pragma unroll
            for (int e4 = 0; e4 < 16; ++e4) { const f32x4 o = *(const LAS f32x4*)(kb + r * 64 + 4 * e4); rank += (o[0] > my) + (o[1] > my) + (o[2] > my) + (o[3] > my); }
            if (rank < TOPK) { const int tl = w * 16 + r; sel_e[tl * 8 + rank] = lane; sel_g[tl * 8 + rank] = sc[r * 64 + lane];
                sel_r[tl * 8 + rank] = __hip_atomic_fetch_add(hist + lane, 1, __ATOMIC_RELAXED, __HIP_MEMORY_SCOPE_WORKGROUP); }
        }
        __syncthreads();
        if (tid < 64) base[tid] = (int)atomicAdd(counts + tid, (unsigned)hist[tid]);
        __syncthreads();
        for (int i = tid; i < 1024; i += NTHREADS) {
            const int e = sel_e[i], pos = base[e] + sel_r[i], token = blk * 128 + (i >> 3);
            const LAS f32x4* g4 = (const LAS f32x4*)(sel_g + (i & ~7)); const f32x4 ga = g4[0], gb = g4[1];
            const float ssum = ((ga[0] + ga[1]) + (ga[2] + ga[3])) + ((gb[0] + gb[1]) + (gb[2] + gb[3]));
            const float rs = sel_rs[i >> 3]; tokl[(size_t)e * NTOK + pos] = token; scl[(size_t)e * NTOK + pos] = (f32x2){rs, rs * sel_g[i] * (ROUTED_SCALE / ssum)}; slot[(size_t)token * 8 + (i & 7)] = (e << 16) | pos;
        }
        __syncthreads();
    }
}

struct CRows { v2u h[4]; unsigned ys[4]; unsigned y[8][4]; };
__device__ __forceinline__ void comb_issue(CRows& r, int tok, int sl, const bf16* H1, const unsigned char* YR, const unsigned char* YS, const MoeTab& T, int c0) {
    asm volatile("" : "+v"(c0));
    const unsigned ho = (unsigned)tok * (D * 2) + 2 * c0, so = (unsigned)tok * D + c0;
#pragma unroll
    for (int j = 0; j < 4; ++j) { r.h[j] = __builtin_nontemporal_load((const v2u*)((const char*)H1 + ho + 512 * j)); r.ys[j] = __builtin_nontemporal_load((const unsigned*)(YS + so + 256 * j)); }
#pragma unroll
    for (int k = 0; k < TOPK; ++k) { const int s = __shfl(sl, k); const int e = s >> 16, pos = s & 0xffff; const unsigned yo = (unsigned)(T.rowbase[e] + pos) * D + c0;
#pragma unroll
        for (int j = 0; j < 4; ++j) r.y[k][j] = __builtin_nontemporal_load((const unsigned*)(YR + yo + 256 * j)); }
}
__device__ __forceinline__ void comb_finish(const CRows& r, int tok, float* out, const float* gf, int c0) {
    float v[16];
#pragma unroll
    for (int j = 0; j < 4; ++j) { v[4 * j] = bflo(r.h[j].x); v[4 * j + 1] = bfhi(r.h[j].x); v[4 * j + 2] = bflo(r.h[j].y); v[4 * j + 3] = bfhi(r.h[j].y); }
#pragma unroll
    for (int k = 0; k <= TOPK; ++k) {
#pragma unroll
        for (int j = 0; j < 4; ++j) { const unsigned yy = (k < TOPK) ? r.y[k < TOPK ? k : 0][j] : r.ys[j];
            const f32x2 lo = __builtin_amdgcn_cvt_pk_f32_fp8((int)yy, false), hi = __builtin_amdgcn_cvt_pk_f32_fp8((int)yy, true);
            v[4 * j] += lo.x * (1.f / YSCALE); v[4 * j + 1] += lo.y * (1.f / YSCALE); v[4 * j + 2] += hi.x * (1.f / YSCALE); v[4 * j + 3] += hi.y * (1.f / YSCALE); }
        asm volatile("" : "+v"(v[0]), "+v"(v[1]), "+v"(v[2]), "+v"(v[3]), "+v"(v[4]), "+v"(v[5]), "+v"(v[6]), "+v"(v[7]), "+v"(v[8]), "+v"(v[9]), "+v"(v[10]), "+v"(v[11]), "+v"(v[12]), "+v"(v[13]), "+v"(v[14]), "+v"(v[15]));
    }
    float ss = 0.f;
#pragma unroll
    for (int j = 0; j < 16; ++j) ss += v[j] * v[j];
    const float rs = rsqf_(wave_sum(ss) * (1.f / D) + EPS);
    float* o = out + (size_t)tok * D + c0;
#pragma unroll
    for (int j = 0; j < 4; ++j) { const f32x4 g = *(const f32x4*)(gf + c0 + 256 * j);
        OUT_STORE(((f32x4){v[4 * j] * rs * g.x, v[4 * j + 1] * rs * g.y, v[4 * j + 2] * rs * g.z, v[4 * j + 3] * rs * g.w}), (f32x4*)(o + 256 * j)); }
}
__device__ __forceinline__ void combine_phase(Frame& F, const MoeTab& T) {
    const bf16* H1 = (const bf16*)(F.ws + WS_H1); const unsigned char* YR = F.ws + WS_YR; const unsigned char* YS = F.ws + WS_YS; const int* slot = (const int*)(F.ws + WS_SLOT); const float* gf = F.in[18];
    const int gw = F.vcu * NWAVES + F.wave, NGW = F.G * NWAVES, lane = F.lane, c0 = 4 * lane;
    if (gw >= NTOK) return;
    CRows ra, rb;
    int tok = gw;
    int sl = slot[(size_t)tok * 8 + (lane & 7)];
    comb_issue(ra, tok, sl, H1, YR, YS, T, c0);
    int sln = (tok + NGW < NTOK) ? slot[(size_t)(tok + NGW) * 8 + (lane & 7)] : 0;
    for (;;) {
        const int t1 = tok + NGW, t2 = tok + 2 * NGW, t3 = tok + 3 * NGW;
        if (t1 < NTOK) comb_issue(rb, t1, sln, H1, YR, YS, T, c0);
        int sl2 = (t2 < NTOK) ? slot[(size_t)t2 * 8 + (lane & 7)] : 0;
        __builtin_amdgcn_sched_barrier(0);
        comb_finish(ra, tok, F.out, gf, c0);
        __builtin_amdgcn_sched_barrier(0);
        if (t1 >= NTOK) break;
        if (t2 < NTOK) comb_issue(ra, t2, sl2, H1, YR, YS, T, c0);
        sln = (t3 < NTOK) ? slot[(size_t)t3 * 8 + (lane & 7)] : 0;
        __builtin_amdgcn_sched_barrier(0);
        comb_finish(rb, t1, F.out, gf, c0);
        __builtin_amdgcn_sched_barrier(0);
        if (t2 >= NTOK) break;
        tok = t2;
    }
}

__global__ void __launch_bounds__(NTHREADS, 2) mega_fwd(Args args) {
    extern __shared__ __attribute__((aligned(16))) unsigned char lds[];
    Frame F;
    F.lds = (LAS unsigned char*)lds;
    F.tid = threadIdx.x; F.lane = F.tid & 63; F.wave = __builtin_amdgcn_readfirstlane(F.tid >> 6);
    F.G = gridDim.x; { const int bx = blockIdx.x; F.vcu = (F.G % 8 == 0) ? (bx % 8) * (F.G / 8) + bx / 8 : bx; }
#pragma unroll
    for (int i = 0; i < 19; ++i) F.in[i] = args.in[i];
    F.out = args.out; F.ws = args.ws;
    volatile LAS unsigned* MISC = (volatile LAS unsigned*)(F.lds + MISC_OFF);
    for (int u = F.tid; u < 32; u += NTHREADS) MISC[u] = 0u;
    __syncthreads();
    unsigned* ctl = (unsigned*)(F.ws + WS_CTL);
    XcdBarrier bar = xcd_barrier_post(ctl + CW_BAR, MISC + 8);
    const int lo = args.ph_lo, hi = args.ph_hi;
#define IN(k) (lo <= (k) && (k) < hi)
#define BOTH(k) (IN(k) && IN((k) + 1))

    if (IN(0)) { REP(0) p0_prologue(F); if (BOTH(0)) xcd_barrier(bar); }
    if (IN(1)) {
        constexpr int GEMM_CUS = GEMM_CUS_CFG;
        if ((int)blockIdx.x < GEMM_CUS || F.G <= GEMM_CUS) {
            ProbIn p{(const bf16*)(F.ws + WS_XN), (const bf16*)(F.ws + WS_WIN), (bf16*)(F.ws + WS_PROJ)};
            const int ge = F.G > GEMM_CUS ? GEMM_CUS : F.G;
#if FAST_GEMM & 1
            REP(1) fg::gemm_phase(F, p, ge);
#else
            simple_gemm_phase(F, p, ge);
#endif
        }
        if (F.G <= GEMM_CUS) { meta_proj(F, F.vcu * NWAVES + F.wave, F.G * NWAVES); if (GEMM_CUS_CFG < 256) p0_convert(F, P0_NONEXPERT + P0_SPLIT, P0_NITEMS, F.vcu * NWAVES + F.wave, F.G * NWAVES); }
        else if ((int)blockIdx.x >= GEMM_CUS) { const int gw = ((int)blockIdx.x - GEMM_CUS) * NWAVES + F.wave, ngw = (F.G - GEMM_CUS) * NWAVES; meta_proj(F, gw, ngw); p0_convert(F, P0_NONEXPERT + P0_SPLIT, P0_NITEMS, gw, ngw); }
        if (BOTH(1)) xcd_barrier(bar); }
#if FAST_HGRN
    if (IN(2)) {
#if HGRN_SEG
        hg::pass_a2(F); xcd_barrier(bar); hg::pass_c2(F);
#else
        REP(2) hg::pass_a(F); xcd_barrier(bar); REP(3) hg::scan_phase(F); xcd_barrier(bar); REP(4) hg::pass_c(F);
#endif
        if (BOTH(2)) xcd_barrier(bar); }
#else
    if (IN(2)) { hgrn_naive(F); if (BOTH(2)) xcd_barrier(bar); }
#endif
#if !FAST_HGRN
    if (IN(3)) { REP(5) post_phase(F); if (BOTH(3)) xcd_barrier(bar); }
#endif
    if (IN(4)) { ProbOut p{(const bf16*)(F.ws + WS_Y), (const bf16*)(F.ws + WS_WOUT), F.in[0], (bf16*)(F.ws + WS_H1), (float*)(F.ws + WS_SUMSQ), ProbE1::FP8 ? F.ws + WS_H1Q : nullptr, (const bf16*)(F.ws + WS_XN), (const float*)(F.ws + WS_RINV)};
#if FAST_GEMM & 2
        fg::gemm_phase(F, p);
#else
        simple_gemm_out(F, p);
#endif
        if (BOTH(4)) xcd_barrier(bar); }
    if (IN(5)) { router_phase(F); if (BOTH(5)) xcd_barrier(bar); }
    MoeTab T; T.cnt = nullptr; T.rowbase = nullptr; T.tb = nullptr;
    if (IN(6) || IN(7) || IN(8)) moe_build_tab(F, T);
    if (IN(6)) { ProbE1 p{T, ProbE1::FP8 ? (const bf16*)(F.ws + WS_H1Q) : (const bf16*)(F.ws + WS_H1), (const bf16*)((unsigned char*)F.out + OUT_WGU), (const int*)(F.ws + WS_TOK), (const f32x2*)(F.ws + WS_SCL), (const f32x2*)(F.ws + WS_SCLS), (bf16*)(F.ws + WS_HID), (LAS int*)(F.lds + IDX_OFF)};
#if FAST_GEMM & 4
        moe_fill_units(F, p, (LAS int*)(F.lds + UT_OFF)); e1_fill_idx(F, p); REP(6) fg::gemm_phase(F, p);
#else
        simple_gemm_phase(F, p);
#endif
        if (BOTH(6)) xcd_barrier(bar); }
    if (IN(7)) { ProbE2 p{T, (const bf16*)(F.ws + WS_HID), (const bf16*)((unsigned char*)F.out + OUT_WD), F.ws + WS_YS, F.ws + WS_YR, 0, 0};
#if (FAST_GEMM & 8) && E2_CUSTOM
        static_assert(ProbE2Q, "the dedicated down-GEMM body is fp8 only");
        p.ntl = 128; fg::gemm_phase(F, p);
        e2::phase(F, T, (const unsigned char*)(F.ws + WS_HID), (const unsigned char*)F.out + OUT_WD, F.ws + WS_YR, F.ws + WS_DD);
#elif FAST_GEMM & 8
        moe_fill_units(F, p, (LAS int*)(F.lds + UT_OFF)); fg::gemm_phase(F, p);
        if ((REPEAT >> 7) & 1) { p.t0 = 128; fg::gemm_phase(F, p); }
#else
        simple_gemm_phase(F, p);
#endif
        if (BOTH(7)) xcd_barrier(bar); }
    if (IN(8)) { REP(8) combine_phase(F, T); for (int _r = 0; _r < ((REPEAT >> 9) & 1) * 8; ++_r) xcd_barrier(bar); }
#undef IN
#undef BOTH
}

extern "C" void kernel_launch(void* const* d_in, const int* in_sizes, int n_in, void* d_out, int out_size, void* d_ws, size_t ws_size, hipStream_t stream) {
    static int grid = 0;
    if (grid == 0) {
        if (n_in != 19 || in_sizes[0] != NTOK * D || out_size != NTOK * D || ws_size < WS_END) { fprintf(stderr, "kernel_launch: unexpected shapes / workspace (n_in %d, in0 %d, out %d, ws %zu)\n", n_in, n_in > 0 ? in_sizes[0] : -1, out_size, ws_size); grid = -1; return; }
        int dev = 0, cus = 0, per_cu = 0;
        if (hipGetDevice(&dev) != hipSuccess || hipDeviceGetAttribute(&cus, hipDeviceAttributeMultiprocessorCount, dev) != hipSuccess) { grid = -1; return; }
        if (hipFuncSetAttribute((const void*)mega_fwd, hipFuncAttributeMaxDynamicSharedMemorySize, LDS_BYTES) != hipSuccess) { fprintf(stderr, "kernel_launch: hipFuncSetAttribute failed\n"); grid = -1; return; }
        if (hipOccupancyMaxActiveBlocksPerMultiprocessor(&per_cu, (const void*)mega_fwd, NTHREADS, LDS_BYTES) != hipSuccess || per_cu < 1) { fprintf(stderr, "kernel_launch: occupancy query reports %d workgroups per CU\n", per_cu); grid = -1; return; }
        if (cus < 256) { fprintf(stderr, "kernel_launch: built for a 256-CU device (per-CU unit tables are sized for a 256-workgroup grid); found %d CUs\n", cus); grid = -1; return; }
        grid = 256;
    }
    if (grid < 0) return;
    (void)hipMemsetAsync((char*)d_ws + WS_CTL, 0, CTL_ZERO_BYTES, stream);
    Args a{};
    for (int i = 0; i < 19; ++i) a.in[i] = (const float*)d_in[i];
    a.out = (float*)d_out; a.ws = (unsigned char*)d_ws; a.ph_lo = 0; a.ph_hi = 9;
    void* kargs[] = {&a};
    const hipError_t e = hipLaunchCooperativeKernel((const void*)mega_fwd, dim3(grid), dim3(NTHREADS), kargs, LDS_BYTES, stream);
    if (e != hipSuccess) fprintf(stderr, "kernel_launch: cooperative launch failed: %s (grid %d)\n", hipGetErrorString(e), grid);
}
```

```cpp
#include <hip/hip_runtime.h>
#include <cstdio>
#include <cstdint>

#define GAS __attribute__((address_space(1)))
#define LAS __attribute__((address_space(3)))
typedef unsigned short bf16;
typedef unsigned v4u __attribute__((ext_vector_type(4)));
typedef unsigned v2u __attribute__((ext_vector_type(2)));
typedef float f32x4 __attribute__((ext_vector_type(4)));
typedef float f32x2 __attribute__((ext_vector_type(2)));
typedef short bf16x8 __attribute__((ext_vector_type(8)));

#ifndef FAST_GEMM
#define FAST_GEMM 15
#endif
#ifndef REPEAT
#define REPEAT 0
#endif
#define REP(k) for (int _rep = 0; _rep < 1 + ((REPEAT >> (k)) & 1); ++_rep)
#ifndef P0_SPLIT
#define P0_SPLIT 12480
#endif
#ifndef GEMM_CUS_CFG
#define GEMM_CUS_CFG 224
#endif
#ifndef HGRN_SEG
#define HGRN_SEG 1
#endif
#ifndef FP8_E1
#define FP8_E1 1
#endif
#ifndef FP8_E2
#define FP8_E2 1
#endif
#ifndef E2_CUSTOM
#define E2_CUSTOM 0
#endif
#ifndef FAST_HGRN
#define FAST_HGRN 1
#endif

constexpr int D = 1024, NB = 4, SEQ = 8192, NMETA = 16, NTOK = NB * SEQ, MROWS = 33024, PW = 3584, HW = 512;
constexpr int NE = 64, TOPK = 8, FF = 256;
constexpr float EPS = 1e-6f, ROUTED_SCALE = 2.5f, YSCALE = 16.f, WQ_SCALE = 32.f, HQ_SCALE = 8.f, WDQ_SCALE = 16.f, F8MAX = 448.f;
constexpr int NWAVES = 8, NTHREADS = NWAVES * 64;
constexpr int LDS_BYTES = 147456;
constexpr int RING_BYTES = 131072, MISC_OFF = RING_BYTES + 320, TAB_OFF = RING_BYTES + 1024, IDX_OFF = RING_BYTES + 2048, UT_OFF = RING_BYTES + 13312;

constexpr size_t MiB = 1u << 20;
constexpr size_t WS_CTL = 0, CTL_ZERO_BYTES = 1 * MiB;
constexpr int CW_BAR = 4096;
constexpr int CW_CNT = 32768;
constexpr size_t WS_SUMSQ = 256 * 1024;
constexpr size_t WS_TOK = 1 * MiB;
constexpr size_t WS_SCL = 9 * MiB;
constexpr size_t WS_SLOT = 25 * MiB;
constexpr size_t WS_SCLS = 26 * MiB;
constexpr size_t WS_RINV = 26 * MiB + 256 * 1024;
constexpr size_t WS_LB = 26 * MiB + 512 * 1024;
constexpr size_t WS_WIN = 27 * MiB;
constexpr size_t WS_WOUT = 34 * MiB;
constexpr size_t WS_WR = 36 * MiB;
constexpr size_t WS_XN = 37 * MiB;
constexpr size_t WS_Y = 429 * MiB;
constexpr size_t WS_PROJ = 102 * MiB;
constexpr size_t WS_ORAW = 328 * MiB;
constexpr size_t WS_DS = 37 * MiB;
constexpr size_t WS_SS = 392 * MiB;
constexpr size_t WS_DD = 494 * MiB;
constexpr size_t WS_DSM = 495 * MiB;
constexpr size_t WS_H1Q = 102 * MiB;
constexpr size_t WS_H1 = 293 * MiB;
constexpr size_t WS_HID = 357 * MiB;
constexpr size_t WS_YR = 37 * MiB;
constexpr size_t WS_YS = 430 * MiB;
constexpr size_t WS_END = 502 * MiB;
constexpr size_t OUT_WGU = 0, OUT_WD = (size_t)65 * 512 * 1024 * 2;

__device__ __forceinline__ float bf2f(bf16 h) { return __builtin_bit_cast(float, (unsigned)h << 16); }
__device__ __forceinline__ float bflo(unsigned w) { return __builtin_bit_cast(float, w << 16); }
__device__ __forceinline__ float bfhi(unsigned w) { return __builtin_bit_cast(float, w & 0xffff0000u); }
typedef __bf16 bf16x2_t __attribute__((ext_vector_type(2)));
__device__ __forceinline__ unsigned pk2(float lo, float hi) { const f32x2 v = {lo, hi}; return __builtin_bit_cast(unsigned, __builtin_convertvector(v, bf16x2_t)); }
__device__ __forceinline__ unsigned f2bf(float f) { return pk2(f, 0.f) & 0xffffu; }
__device__ __forceinline__ float fexp_(float x) { return __builtin_amdgcn_exp2f(x * 1.4426950408889634f); }
__device__ __forceinline__ float flog_(float x) { return __builtin_amdgcn_logf(x) * 0.6931471805599453f; }
__device__ __forceinline__ float rcpf_(float x) { return __builtin_amdgcn_rcpf(x); }
__device__ __forceinline__ float rsqf_(float x) { return __builtin_amdgcn_rsqf(x); }
__device__ __forceinline__ float sigmoidf_(float x) { return rcpf_(1.f + fexp_(-x)); }
__device__ __forceinline__ float siluf_(float x) { return x * rcpf_(1.f + fexp_(-x)); }
#define LDS_WAIT() asm volatile("s_waitcnt lgkmcnt(0)" ::: "memory")
#define WG_BARRIER() do { asm volatile("s_waitcnt lgkmcnt(0)" ::: "memory"); __builtin_amdgcn_s_barrier(); asm volatile("" ::: "memory"); } while (0)
#define VM_WAIT() asm volatile("s_waitcnt vmcnt(0)" ::: "memory")

#define XB_TMO      128
#define XB_XCNT(j)  (256  + 64 * (j))
#define XB_XSUB(j)  (1280 + 64 * (j))
#define XB_XGEN(j)  (2304 + 64 * (j))
#define XB_TOP      3328
#define XB_TOPGEN   3392
#define XCD_BAR_WORDS 3456
#define XB_SPIN_CAP (1u << 18)
__device__ __forceinline__ unsigned xb_ld(unsigned* p)              { return __hip_atomic_load(p, __ATOMIC_RELAXED, __HIP_MEMORY_SCOPE_AGENT); }
__device__ __forceinline__ unsigned xb_add(unsigned* p, unsigned v) { return __hip_atomic_fetch_add(p, v, __ATOMIC_RELAXED, __HIP_MEMORY_SCOPE_AGENT); }
__device__ __forceinline__ unsigned xb_xcc_id() { return (unsigned)__builtin_amdgcn_s_getreg((3 << 11) | 20) & 0xFu; }
#define XB_SPIN(cond, bar) do { unsigned _sp = 0; while (cond) { __builtin_amdgcn_s_sleep(1); \
    if ((++_sp & 255u) == 0u) { if (xb_ld(&(bar)[XB_TMO])) break; if (_sp > XB_SPIN_CAP) { atomicAdd(&(bar)[XB_TMO], 1u); break; } } } } while (0)
struct XcdBarrier { unsigned* bar; unsigned x; volatile LAS unsigned* st; };
__device__ __forceinline__ XcdBarrier xcd_barrier_post(unsigned* bar, volatile LAS unsigned* st) {
    XcdBarrier b; b.bar = bar; b.x = xb_xcc_id(); b.st = st;
    if (threadIdx.x == 0) (void)xb_add(&bar[XB_XCNT(b.x)], 1u);
    return b;
}
__device__ __forceinline__ void xcd_barrier_complete(unsigned* bar, unsigned x, unsigned& nloc, unsigned& nx) {
    const unsigned G = gridDim.x * gridDim.y * gridDim.z;
    unsigned sum, cnt, mine, sp = 0u;
    for (;;) {
        sum = 0u; cnt = 0u; mine = 0u;
#pragma unroll
        for (unsigned j = 0; j < 16; ++j) { const unsigned c = xb_ld(&bar[XB_XCNT(j)]); sum += c; cnt += (c > 0u) ? 1u : 0u; mine = (j == x) ? c : mine; }
        if (sum == G) break;
        __builtin_amdgcn_s_sleep(1);
        if ((++sp & 255u) == 0u) { if (xb_ld(&bar[XB_TMO])) break; if (sp > XB_SPIN_CAP) { atomicAdd(&bar[XB_TMO], 1u); break; } }
    }
    nloc = mine > 0u ? mine : 1u; nx = cnt > 0u ? cnt : 1u;
}
__device__ __forceinline__ void xcd_barrier(const XcdBarrier& b) {
    asm volatile("s_waitcnt vmcnt(0)" ::: "memory");
    __syncthreads();
    if (threadIdx.x == 0) {
        unsigned* bar = b.bar;
        __builtin_amdgcn_s_waitcnt(0);
        unsigned nloc = b.st[0], nx = b.st[1];
        if (nloc == 0u) { xcd_barrier_complete(bar, b.x, nloc, nx); b.st[0] = nloc; b.st[1] = nx; }
        const unsigned old = xb_add(&bar[XB_XSUB(b.x)], 1u);
        const unsigned gen = old / nloc;
        if (old + 1u == (gen + 1u) * nloc) {
            __builtin_amdgcn_fence(__ATOMIC_RELEASE, "agent");
            asm volatile("s_waitcnt vmcnt(0)" ::: "memory");
            const unsigned og = xb_add(&bar[XB_TOP], 1u);
            const unsigned tg = og / nx;
            if (og + 1u == (tg + 1u) * nx) xb_add(&bar[XB_TOPGEN], 1u);
            else XB_SPIN(xb_ld(&bar[XB_TOPGEN]) == tg, bar);
            __builtin_amdgcn_fence(__ATOMIC_ACQUIRE, "agent");
            xb_add(&bar[XB_XGEN(b.x)], 1u);
            asm volatile("s_waitcnt vmcnt(0)" ::: "memory");
        } else {
            XB_SPIN(xb_ld(&bar[XB_XGEN(b.x)]) == gen, bar);
            __builtin_amdgcn_fence(__ATOMIC_ACQUIRE, "agent");
            asm volatile("s_waitcnt vmcnt(0)" ::: "memory");
        }
    }
    __syncthreads();
}

struct Args { const float* in[19]; float* out; unsigned char* ws; int ph_lo, ph_hi; };
struct Frame {
    LAS unsigned char* lds;
    int tid, lane, wave, G, vcu;
    const float* in[19]; float* out; unsigned char* ws;
};
__device__ __forceinline__ float wave_sum(float v) {
#pragma unroll
    for (int o = 1; o < 64; o <<= 1) v += __shfl_xor(v, o);
    return v;
}

constexpr bool ProbE1Q = (FP8_E1 != 0) && ((FAST_GEMM & 4) != 0), ProbE2Q = (FP8_E2 != 0) && ((FAST_GEMM & 8) != 0) && ((FAST_GEMM & 4) != 0);
struct P0Item { const float* W; bf16* WT; const float* kscale; int K, N, k0, n0, orow0, q8; float qs; };
__device__ __forceinline__ void p0_item(Frame& F, int it, P0Item& I) {
    bf16* WinT = (bf16*)(F.ws + WS_WIN); bf16* WoutT = (bf16*)(F.ws + WS_WOUT); bf16* WrT = (bf16*)(F.ws + WS_WR);
    bf16* WGU = (bf16*)((unsigned char*)F.out + OUT_WGU); bf16* WD = (bf16*)((unsigned char*)F.out + OUT_WD);
    constexpr int I_IN = 16 * 112, I_OUT = 16 * 32, I_R = 16 * 2, I_E = 384;
    int r = it;
    if (r < I_IN) { I.W = F.in[3]; I.q8 = 0; I.WT = WinT; I.kscale = F.in[2]; I.K = D; I.N = PW; I.k0 = 64 * (r / 112); I.n0 = 32 * (r % 112); I.orow0 = I.n0; return; } r -= I_IN;
    if (r < I_OUT) { I.W = F.in[8]; I.q8 = 0; I.WT = WoutT; I.kscale = nullptr; I.K = D; I.N = D; I.k0 = 64 * (r / 32); I.n0 = 32 * (r % 32); I.orow0 = I.n0; return; } r -= I_OUT;
    if (r < I_R) { I.W = F.in[10]; I.q8 = 0; I.WT = WrT; I.kscale = F.in[9]; I.K = D; I.N = NE; I.k0 = 64 * (r / 2); I.n0 = 32 * (r % 2); I.orow0 = I.n0; return; } r -= I_R;
    const int e = r / I_E, q = r % I_E, kind = q / 128, idx = q % 128;
    if (kind < 2) {
        I.W = (e < NE) ? (kind == 0 ? F.in[12] : F.in[13]) + (size_t)e * D * FF : (kind == 0 ? F.in[15] : F.in[16]);
        I.q8 = ProbE1Q ? 1 : 0; I.qs = WQ_SCALE; I.WT = ProbE1Q ? (bf16*)((unsigned char*)WGU + (size_t)e * 512 * D) : WGU + (size_t)e * 512 * D; I.kscale = F.in[9]; I.K = D; I.N = FF; I.k0 = 64 * (idx / 8); I.n0 = 32 * (idx % 8); I.orow0 = (I.n0 / 128) * 256 + (kind == 1 ? 128 : 0) + (I.n0 % 128);
    } else {
        I.W = (e < NE) ? F.in[14] + (size_t)e * FF * D : F.in[17];
        I.q8 = ProbE2Q ? 1 : 0; I.qs = WDQ_SCALE; I.WT = ProbE2Q ? (bf16*)((unsigned char*)WD + (size_t)e * D * FF) : WD + (size_t)e * D * FF; I.kscale = nullptr; I.K = FF; I.N = D; I.k0 = 64 * (idx / 32); I.n0 = 32 * (idx % 32); I.orow0 = I.n0;
    }
}
__device__ __forceinline__ void p0_load(const P0Item& I, int lane, f32x4 (&v)[8]) {
#pragma unroll
    for (int i = 0; i < 8; ++i) { const int kk = 8 * i + (lane >> 3); v[i] = __builtin_nontemporal_load((const f32x4*)(I.W + (size_t)(I.k0 + kk) * I.N + I.n0 + 4 * (lane & 7))); }
}
__device__ __forceinline__ void p0_store(const P0Item& I, int lane, f32x4 (&v)[8], LAS float* scr) {
    if (I.kscale) {
#pragma unroll
        for (int i = 0; i < 8; ++i) v[i] *= I.kscale[I.k0 + 8 * i + (lane >> 3)];
    }
#pragma unroll
    for (int i = 0; i < 8; ++i) { LAS float* d = scr + (8 * i + (lane >> 3)) * 33 + 4 * (lane & 7); d[0] = v[i][0]; d[1] = v[i][1]; d[2] = v[i][2]; d[3] = v[i][3]; }
    LDS_WAIT(); asm volatile("" ::: "memory");
    if (I.q8) {
        const int c = lane & 3;
#pragma unroll
        for (int j = 0; j < 2; ++j) { const int n = (lane >> 2) + 16 * j; const LAS float* s = scr + (16 * c) * 33 + n; unsigned w[4];
#pragma unroll
            for (int q = 0; q < 4; ++q) { int t = __builtin_amdgcn_cvt_pk_fp8_f32(s[(4 * q) * 33] * I.qs, s[(4 * q + 1) * 33] * I.qs, 0, false); t = __builtin_amdgcn_cvt_pk_fp8_f32(s[(4 * q + 2) * 33] * I.qs, s[(4 * q + 3) * 33] * I.qs, t, true); w[q] = (unsigned)t; }
            __builtin_nontemporal_store((v4u){w[0], w[1], w[2], w[3]}, (v4u*)((unsigned char*)I.WT + (size_t)(I.orow0 + n) * I.K + I.k0 + 16 * c)); }
    } else {
    const int c = lane & 7;
#pragma unroll
    for (int j = 0; j < 4; ++j) { const int n = (lane >> 3) + 8 * j; const LAS float* s = scr + (8 * c) * 33 + n;
        v4u o; o.x = pk2(s[0 * 33], s[1 * 33]); o.y = pk2(s[2 * 33], s[3 * 33]); o.z = pk2(s[4 * 33], s[5 * 33]); o.w = pk2(s[6 * 33], s[7 * 33]);
        *(v4u*)(I.WT + (size_t)(I.orow0 + n) * I.K + I.k0 + 8 * c) = o; }
    }
    LDS_WAIT(); asm volatile("" ::: "memory");
}
__device__ __forceinline__ void p0_xn_row(Frame& F, int m, bf16* XN, int lane) {
    v2u* o8 = (v2u*)(XN + (size_t)m * D) + lane;
    if (m >= NTOK + NMETA) {
#pragma unroll
        for (int j = 0; j < 4; ++j) o8[64 * j] = (v2u){0u, 0u};
        return;
    }
    const float* xrow = (m < NTOK) ? F.in[0] + (size_t)m * D : F.in[1] + (size_t)(m - NTOK) * D;
    const f32x4* xr = (const f32x4*)xrow + lane;
    f32x4 v[4]; float s = 0.f;
#pragma unroll
    for (int j = 0; j < 4; ++j) { v[j] = __builtin_nontemporal_load(xr + 64 * j); s += (v[j].x * v[j].x + v[j].y * v[j].y) + (v[j].z * v[j].z + v[j].w * v[j].w); }
    const float ms = wave_sum(s) * (1.f / D) + EPS, rstd = rsqf_(ms);
    if (m < NTOK && lane == 0) ((float*)(F.ws + WS_RINV))[m] = ms * rstd;
#pragma unroll
    for (int j = 0; j < 4; ++j) o8[64 * j] = (v2u){pk2(v[j].x * rstd, v[j].y * rstd), pk2(v[j].z * rstd, v[j].w * rstd)};
}
constexpr int P0_NONEXPERT = 16 * 112 + 16 * 32 + 16 * 2, P0_NITEMS = P0_NONEXPERT + 65 * 384;
__device__ __forceinline__ void p0_convert(Frame& F, int lo, int hi, int gw, int NGW) {
    LAS float* scr = (LAS float*)(F.lds + F.wave * 16384); const int lane = F.lane;
    if (lo + gw >= hi) return;
    P0Item cur, nxt; f32x4 va[8], vb[8];
    p0_item(F, lo + gw, cur); p0_load(cur, lane, va);
    for (int it = lo + gw; it < hi; it += 2 * NGW) {
        const bool h1 = it + NGW < hi;
        if (h1) { p0_item(F, it + NGW, nxt); p0_load(nxt, lane, vb); }
        p0_store(cur, lane, va, scr);
        const bool h2 = it + 2 * NGW < hi;
        if (h2) { p0_item(F, it + 2 * NGW, cur); p0_load(cur, lane, va); }
        if (h1) p0_store(nxt, lane, vb, scr);
    }
}
__device__ __forceinline__ void meta_proj(Frame& F, int gw, int NGW) {
    const bf16* XN = (const bf16*)(F.ws + WS_XN); const bf16* W = (const bf16*)(F.ws + WS_WIN); bf16* PROJ = (bf16*)(F.ws + WS_PROJ);
    const int lane = F.lane, fr = lane & 15, fq = lane >> 4;
    for (int nt = gw; nt < PW / 16; nt += NGW) {
        f32x4 acc = {0.f, 0.f, 0.f, 0.f};
        const bf16* ap = XN + (size_t)(NTOK + fr) * D + 8 * fq; const bf16* bp = W + (size_t)(16 * nt + fr) * D + 8 * fq;
#pragma unroll 8
        for (int k0 = 0; k0 < D; k0 += 32) acc = __builtin_amdgcn_mfma_f32_16x16x32_bf16(*(const bf16x8*)(ap + k0), *(const bf16x8*)(bp + k0), acc, 0, 0, 0);
#pragma unroll
        for (int j = 0; j < 4; ++j) PROJ[(size_t)(NTOK + 4 * fq + j) * PW + 16 * nt + fr] = (bf16)f2bf(acc[j]);
    }
}
__device__ __forceinline__ void p0_prologue(Frame& F) {
    const int gw = F.vcu * NWAVES + F.wave, NGW = F.G * NWAVES, lane = F.lane;
    bf16* XN = (bf16*)(F.ws + WS_XN);
    for (int m = gw; m < MROWS; m += NGW) p0_xn_row(F, m, XN, lane);
    p0_convert(F, 0, (GEMM_CUS_CFG >= 256) ? P0_NITEMS : P0_NONEXPERT + P0_SPLIT, gw, NGW);
    if (blockIdx.x == 0) {
        float* LB = (float*)(F.ws + WS_LB);
        const float t0 = F.in[4][F.tid], t1 = F.in[4][HW + F.tid];
        LB[F.tid] = 1.f / (1.f + fexp_(t1 - t0));
    }
}

struct Unit { int pm, pn, e, rows; };
struct MoeTab { LAS int* cnt; LAS int* rowbase; LAS int* tb; };
__device__ __forceinline__ void moe_build_tab(Frame& F, MoeTab& T) {
    T.cnt = (LAS int*)(F.lds + TAB_OFF); T.rowbase = T.cnt + 64; T.tb = T.rowbase + 65;
    if (F.tid < NE) {
        const unsigned* counts = (const unsigned*)(F.ws + WS_CTL) + CW_CNT;
        const int c = (int)__hip_atomic_load(counts + F.tid, __ATOMIC_RELAXED, __HIP_MEMORY_SCOPE_AGENT), t = (c + 255) >> 8;
        int rb = c, tb = t;
#pragma unroll
        for (int o = 1; o < 64; o <<= 1) { const int a = __shfl_up(rb, o), b = __shfl_up(tb, o); if (F.lane >= o) { rb += a; tb += b; } }
        T.cnt[F.tid] = c; T.rowbase[F.tid] = rb - c; T.tb[F.tid] = tb - t;
        if (F.tid == NE - 1) { T.rowbase[NE] = rb; T.tb[NE] = tb; }
    }
    __syncthreads();
}
__device__ __forceinline__ void moe_tile(const MoeTab& T, int tile, Unit& u) {
    if (tile < 128) { u.e = NE; u.pm = tile * 256; u.rows = 256; return; }
    const int t = tile - 128; int lo = 0, hi = NE - 1;
    while (lo < hi) { const int mid = (lo + hi + 1) >> 1; if (T.tb[mid] <= t) lo = mid; else hi = mid - 1; }
    u.e = lo; const int rt = t - T.tb[lo]; u.pm = rt * 256; const int left = T.cnt[lo] - rt * 256; u.rows = left < 256 ? left : 256;
}
__device__ __forceinline__ void dense_unit(int L, int nM, int nN, Unit& u) {
    const int nwg = nM * nN; int wgid = L; { const int q = nwg / 8, r = nwg % 8, xcd = wgid % 8, off = wgid / 8; wgid = (xcd < r ? xcd * (q + 1) : r * (q + 1) + (xcd - r) * q) + off; }
    const int nig = 8 * nN, gid = wgid / nig, fm = gid * 8, gsz = (nM - fm) < 8 ? (nM - fm) : 8;
    u.pm = fm + ((wgid % nig) % gsz); u.pn = (wgid % nig) / gsz; u.e = 0; u.rows = 256;
}
__device__ __forceinline__ unsigned cvt_pk_bf16(float lo, float hi) { unsigned r; asm volatile("v_cvt_pk_bf16_f32 %0, %1, %2" : "=v"(r) : "v"(lo), "v"(hi)); return r; }
__device__ __forceinline__ v4u pack8(const f32x4& a, const f32x4& b) { v4u w; w.x = cvt_pk_bf16(a[0], a[1]); w.y = cvt_pk_bf16(a[2], a[3]); w.z = cvt_pk_bf16(b[0], b[1]); w.w = cvt_pk_bf16(b[2], b[3]); return w; }
typedef f32x4 AccT[2][2][4][2];
__device__ __forceinline__ int bcol_wide(int bj, int slot) { const int wc = slot >> 5, rho = slot & 31, n = rho >> 4, i = rho & 15; return 64 * wc + 16 * (i >> 2) + 8 * bj + 4 * n + (i & 3); }
__device__ __forceinline__ int bcol_split(int bj, int slot) { const int wc = slot >> 5, rho = slot & 31, n = rho >> 4, i = rho & 15; return 64 * wc + 32 * bj + 8 * (i >> 2) + 4 * n + (i & 3); }
__device__ __forceinline__ int bcol_pair(int bj, int slot) { const int rho = slot & 31, n = rho >> 4, i = rho & 15; return 128 * bj + (slot & ~31) + 8 * (i >> 2) + 4 * n + (i & 3); }

#ifndef LDS_LINES
#define LDS_LINES 1
#endif
#ifndef OUT_NT
#define OUT_NT 0
#endif
#if OUT_NT
#define OUT_STORE(v, p) __builtin_nontemporal_store((v), (p))
#else
#define OUT_STORE(v, p) (*(p) = (v))
#endif
#ifndef PROJ_NT
#define PROJ_NT 1
#endif
#if PROJ_NT
#define PROJ_STORE(v, p) __builtin_nontemporal_store((v), (p))
#else
#define PROJ_STORE(v, p) (*(p) = (v))
#endif
struct ProbIn {
    static constexpr int K = D; static constexpr bool PAIR = false, RAW_BX = true, FP8 = false; static constexpr int MSCALE = 127;
    const bf16* XN; const bf16* W; bf16* PROJ;
    __device__ __forceinline__ int nunits() const { return 128 * 14; }
    __device__ __forceinline__ void unit(int L, Unit& u, int = -1) const { dense_unit(L, 128, 14, u); }
    __device__ __forceinline__ const bf16* arow(const Unit& u, int r) const { return XN + (size_t)(u.pm * 256 + r) * D; }
    __device__ __forceinline__ const bf16* brow(const Unit& u, int c) const { return W + (size_t)(u.pn * 256 + c) * D; }
    __device__ __forceinline__ void store(const Unit& u, int r, int c, float v) const { PROJ[(size_t)(u.pm * 256 + r) * PW + u.pn * 256 + c] = (bf16)f2bf(v); }
    __device__ __forceinline__ const char* abase() const { return (const char*)XN; }
    __device__ __forceinline__ unsigned aoff(const Unit& u, int, int r, int c) const { return (unsigned)((u.pm * 256 + r) * D + c) * 2u; }
    __device__ __forceinline__ const char* bbase(const Unit& u) const { return (const char*)(W + (size_t)u.pn * 256 * D); }
    static __device__ __forceinline__ int bcol(int bj, int slot) { return bcol_split(bj, slot); }
    __device__ __forceinline__ void epi(const AccT& acc, const Unit& u, int wr, int wc, int fr, int fq) const {
#pragma unroll
        for (int ai = 0; ai < 2; ++ai)
#pragma unroll
            for (int m = 0; m < 4; ++m) {
                const v4u w0 = pack8(acc[ai][0][m][0], acc[ai][0][m][1]), w1 = pack8(acc[ai][1][m][0], acc[ai][1][m][1]);
                const bool odd = fr & 1;
                const v4u snd = odd ? w0 : w1; v4u rcv;
                rcv.x = (unsigned)__builtin_amdgcn_mov_dpp((int)snd.x, 0xB1, 0xF, 0xF, true); rcv.y = (unsigned)__builtin_amdgcn_mov_dpp((int)snd.y, 0xB1, 0xF, 0xF, true);
                rcv.z = (unsigned)__builtin_amdgcn_mov_dpp((int)snd.z, 0xB1, 0xF, 0xF, true); rcv.w = (unsigned)__builtin_amdgcn_mov_dpp((int)snd.w, 0xB1, 0xF, 0xF, true);
                bf16* rowp = PROJ + (size_t)(u.pm * 256 + 128 * ai + 64 * wr + 16 * m + (fr & ~1)) * PW + u.pn * 256 + 64 * wc + 8 * fq + (odd ? 32 : 0);
                PROJ_STORE(odd ? rcv : w0, (v4u*)rowp); PROJ_STORE(odd ? w1 : rcv, (v4u*)(rowp + PW)); }
    }
};
struct ProbOut {
    static constexpr int K = D; static constexpr bool PAIR = false, RAW_BX = true, FP8 = false; static constexpr int MSCALE = 127;
    const bf16* Y; const bf16* W; const float* x; bf16* H1; float* sumsq; unsigned char* H1q; const bf16* XNr; const float* rinv;
    __device__ __forceinline__ int nunits() const { return 128 * 4; }
    __device__ __forceinline__ void unit(int L, Unit& u, int = -1) const { dense_unit(L, 128, 4, u); }
    __device__ __forceinline__ const bf16* arow(const Unit& u, int r) const { return Y + (size_t)(u.pm * 256 + r) * D; }
    __device__ __forceinline__ const bf16* brow(const Unit& u, int c) const { return W + (size_t)(u.pn * 256 + c) * D; }
    __device__ __forceinline__ const char* abase() const { return (const char*)Y; }
    __device__ __forceinline__ unsigned aoff(const Unit& u, int, int r, int c) const { return (unsigned)((u.pm * 256 + r) * D + c) * 2u; }
    __device__ __forceinline__ const char* bbase(const Unit& u) const { return (const char*)(W + (size_t)u.pn * 256 * D); }
    static __device__ __forceinline__ int bcol(int bj, int slot) { return bcol_split(bj, slot); }
    static __device__ __forceinline__ v4u swap4(const v4u& a) { v4u r; r.x = (unsigned)__builtin_amdgcn_mov_dpp((int)a.x, 0xB1, 0xF, 0xF, true); r.y = (unsigned)__builtin_amdgcn_mov_dpp((int)a.y, 0xB1, 0xF, 0xF, true);
        r.z = (unsigned)__builtin_amdgcn_mov_dpp((int)a.z, 0xB1, 0xF, 0xF, true); r.w = (unsigned)__builtin_amdgcn_mov_dpp((int)a.w, 0xB1, 0xF, 0xF, true); return r; }
    __device__ __forceinline__ void epi(const AccT& acc, const Unit& u, int wr, int wc, int fr, int fq) const {
        const bool odd = fr & 1;
#pragma unroll
        for (int ai = 0; ai < 2; ++ai)
#pragma unroll
            for (int m = 0; m < 4; ++m) {
                const int rowe = u.pm * 256 + 128 * ai + 64 * wr + 16 * m + (fr & ~1), row = rowe + (odd ? 1 : 0);
                const size_t oe = (size_t)rowe * D + u.pn * 256 + 64 * wc + 8 * fq + (odd ? 32 : 0);
                const float ri = rinv[row];
                const v4u la = *(const v4u*)(XNr + oe), lb = *(const v4u*)(XNr + oe + D);
                const v4u xr = swap4(odd ? la : lb);
                const v4u xw[2] = {odd ? xr : la, odd ? lb : xr};
                float ss = 0.f; v4u hw[2]; v2u q8[2];
#pragma unroll
                for (int bj = 0; bj < 2; ++bj) {
                    const f32x4 x0 = (f32x4){bflo(xw[bj].x), bfhi(xw[bj].x), bflo(xw[bj].y), bfhi(xw[bj].y)} * ri, x1 = (f32x4){bflo(xw[bj].z), bfhi(xw[bj].z), bflo(xw[bj].w), bfhi(xw[bj].w)} * ri;
                    const f32x4 v0 = acc[ai][bj][m][0] + x0, v1 = acc[ai][bj][m][1] + x1;
                    ss += (v0[0] * v0[0] + v0[1] * v0[1]) + (v0[2] * v0[2] + v0[3] * v0[3]) + (v1[0] * v1[0] + v1[1] * v1[1]) + (v1[2] * v1[2] + v1[3] * v1[3]);
                    hw[bj] = pack8(v0, v1);
                    if (H1q) { int w0 = __builtin_amdgcn_cvt_pk_fp8_f32(v0[0], v0[1], 0, false); w0 = __builtin_amdgcn_cvt_pk_fp8_f32(v0[2], v0[3], w0, true);
                        int w1 = __builtin_amdgcn_cvt_pk_fp8_f32(v1[0], v1[1], 0, false); w1 = __builtin_amdgcn_cvt_pk_fp8_f32(v1[2], v1[3], w1, true);
                        q8[bj] = (v2u){(unsigned)w0, (unsigned)w1}; }
                }
                { const v4u hr = swap4(odd ? hw[0] : hw[1]);
                  *(v4u*)(H1 + oe) = odd ? hr : hw[0]; *(v4u*)(H1 + oe + D) = odd ? hw[1] : hr; }
                if (H1q) { const v2u qs = odd ? q8[0] : q8[1]; v2u qr; qr.x = (unsigned)__builtin_amdgcn_mov_dpp((int)qs.x, 0xB1, 0xF, 0xF, true); qr.y = (unsigned)__builtin_amdgcn_mov_dpp((int)qs.y, 0xB1, 0xF, 0xF, true);
                  *(v2u*)(H1q + oe) = odd ? qr : q8[0]; *(v2u*)(H1q + oe + D) = odd ? q8[1] : qr; }
                ss += __shfl_xor(ss, 16); ss += __shfl_xor(ss, 32);
                if (fq == 0) atomicAdd(sumsq + row, ss);
            }
    }
};
struct ProbE1 {
    static constexpr bool FP8 = (FP8_E1 != 0) && ((FAST_GEMM & 4) != 0), PAIR = true, RAW_BX = false;
    static constexpr int MSCALE = 122;
    static_assert(WQ_SCALE == 32.f, "MSCALE assumes WQ_SCALE = 32");
    static constexpr int K = FP8 ? D / 2 : D;
    MoeTab T; const bf16* H1; const bf16* WGU; const int* tok; const f32x2* scl; const f32x2* scls; bf16* HID; LAS int* idx;
    __device__ __forceinline__ int nunits() const { return (128 + T.tb[NE]) * 2; }
    LAS int* ut = nullptr;
    __device__ __forceinline__ void unit(int i, Unit& u, int slot = -1) const { if (slot >= 0 && ut) { const LAS int* q = ut + 4 * slot; u.e = q[0]; u.pm = q[1]; u.rows = q[2]; u.pn = q[3]; return; } moe_tile(T, i >> 1, u); u.pn = i & 1; }
    __device__ __forceinline__ int token(const Unit& u, int r) const { if (u.e == NE) return u.pm + r; const int rr = (r < u.rows) ? u.pm + r : u.pm; return tok[(size_t)u.e * NTOK + rr]; }
    __device__ __forceinline__ const bf16* arow(const Unit& u, int r) const { return H1 + (size_t)token(u, r) * D; }
    __device__ __forceinline__ const bf16* brow(const Unit& u, int c) const { return WGU + ((size_t)u.e * 512 + u.pn * 256 + c) * D; }
    __device__ __forceinline__ size_t hidrow(const Unit& u, int r) const { return (u.e == NE) ? (size_t)(u.pm + r) : (size_t)(NTOK + T.rowbase[u.e] + u.pm + r); }
    __device__ __forceinline__ f32x2 scale(const Unit& u, int r) const { return (u.e == NE) ? scls[u.pm + r] : scl[(size_t)u.e * NTOK + u.pm + r]; }
    __device__ __forceinline__ void store2(const Unit& u, int r, int c, float g, float up) const {
        if (r >= u.rows) return;
        const f32x2 sc = scale(u, r);
        HID[hidrow(u, r) * FF + u.pn * 128 + c] = (bf16)f2bf(siluf_(g * sc.x) * up * sc.y);
    }
    __device__ __forceinline__ const char* abase() const { return (const char*)H1; }
    __device__ __forceinline__ unsigned aoff(const Unit& u, int slot, int r, int c) const { const int t = (u.e == NE) ? u.pm + r : idx[slot * 256 + r]; return (unsigned)(t * K + c) * 2u; }
    __device__ __forceinline__ const char* bbase(const Unit& u) const { return (const char*)WGU + ((size_t)u.e * 512 + u.pn * 256) * K * 2; }
    static __device__ __forceinline__ int bcol(int bj, int slot) { return bcol_pair(bj, slot); }
    __device__ __forceinline__ void epi(const AccT& acc, const Unit& u, int wr, int wc, int fr, int fq) const {
        const size_t hb = hidrow(u, 0);
#pragma unroll
        for (int ai = 0; ai < 2; ++ai)
#pragma unroll
            for (int m = 0; m < 4; ++m) {
                const int r = 128 * ai + 64 * wr + 16 * m + fr;
                if (r < u.rows) {
                    f32x2 sc = scale(u, r); if (ProbE2Q) sc.y *= HQ_SCALE;
                    f32x4 h0, h1;
#pragma unroll
                    for (int j = 0; j < 4; ++j) { h0[j] = siluf_(acc[ai][0][m][0][j] * sc.x) * acc[ai][1][m][0][j] * sc.y; h1[j] = siluf_(acc[ai][0][m][1][j] * sc.x) * acc[ai][1][m][1][j] * sc.y; }
                    if (ProbE2Q) {
#pragma unroll
                        for (int j = 0; j < 4; ++j) { h0[j] = __builtin_amdgcn_fmed3f(h0[j], -F8MAX, F8MAX); h1[j] = __builtin_amdgcn_fmed3f(h1[j], -F8MAX, F8MAX); }
                        int w0 = __builtin_amdgcn_cvt_pk_fp8_f32(h0[0], h0[1], 0, false); w0 = __builtin_amdgcn_cvt_pk_fp8_f32(h0[2], h0[3], w0, true);
                        int w1 = __builtin_amdgcn_cvt_pk_fp8_f32(h1[0], h1[1], 0, false); w1 = __builtin_amdgcn_cvt_pk_fp8_f32(h1[2], h1[3], w1, true);
                        *(v2u*)((unsigned char*)HID + (hb + r) * FF + u.pn * 128 + 32 * wc + 8 * fq) = (v2u){(unsigned)w0, (unsigned)w1}; }
                    else *(v4u*)(HID + (hb + r) * FF + u.pn * 128 + 32 * wc + 8 * fq) = pack8(h0, h1);
                }
            }
    }
};
struct ProbE2 {
    static constexpr bool PAIR = false, RAW_BX = false, FP8 = ProbE2Q;
    static constexpr int MSCALE = FP8 ? 124 : 127;
    static_assert(YSCALE * 8.f == HQ_SCALE * WDQ_SCALE, "MSCALE assumes YSCALE / (HQ_SCALE * WDQ_SCALE) = 1/8");
    static constexpr int K = FP8 ? FF / 2 : FF;
    MoeTab T; const bf16* HID; const bf16* WD; unsigned char* YS; unsigned char* YR; int t0; int ntl;
    __device__ __forceinline__ int nunits() const { return (ntl > 0 ? ntl : 128 - t0 + T.tb[NE]) * 4; }
    LAS int* ut = nullptr;
    __device__ __forceinline__ void unit(int i, Unit& u, int slot = -1) const { if (slot >= 0 && ut) { const LAS int* q = ut + 4 * slot; u.e = q[0]; u.pm = q[1]; u.rows = q[2]; u.pn = q[3]; return; } moe_tile(T, (i >> 2) + t0, u); u.pn = i & 3; }
    __device__ __forceinline__ size_t hidrow(const Unit& u, int r) const { return (u.e == NE) ? (size_t)(u.pm + r) : (size_t)(NTOK + T.rowbase[u.e] + u.pm + r); }
    __device__ __forceinline__ const bf16* arow(const Unit& u, int r) const { return HID + hidrow(u, r) * FF; }
    __device__ __forceinline__ const bf16* brow(const Unit& u, int c) const { return WD + ((size_t)u.e * D + u.pn * 256 + c) * FF; }
    __device__ __forceinline__ void store(const Unit& u, int r, int c, float v) const {
        if (r >= u.rows) return;
        if (u.e == NE) { const int w = __builtin_amdgcn_cvt_pk_fp8_f32(v * YSCALE, 0.f, 0, false); YS[(size_t)(u.pm + r) * D + u.pn * 256 + c] = (unsigned char)(w & 0xff); }
        else { const int w = __builtin_amdgcn_cvt_pk_fp8_f32(v * YSCALE, 0.f, 0, false); YR[(size_t)(T.rowbase[u.e] + u.pm + r) * D + u.pn * 256 + c] = (unsigned char)(w & 0xff); }
    }
    __device__ __forceinline__ const char* abase() const { return (const char*)HID; }
    __device__ __forceinline__ unsigned aoff(const Unit& u, int, int r, int c) const { return (unsigned)(((unsigned)hidrow(u, 0) + (unsigned)r) * K + c) * 2u; }
    __device__ __forceinline__ const char* bbase(const Unit& u) const { return (const char*)WD + ((size_t)u.e * D + u.pn * 256) * K * 2; }
    static __device__ __forceinline__ int bcol(int bj, int slot) { return bcol_wide(bj, slot); }
    __device__ __forceinline__ void epi(const AccT& acc, const Unit& u, int wr, int wc, int fr, int fq) const {
        const int cb = u.pn * 256 + 64 * wc + 16 * fq;
        constexpr float dq = FP8 ? 1.f / (HQ_SCALE * WDQ_SCALE) : 1.f;
        unsigned char* yb = (u.e == NE) ? YS : YR; const int row0 = (u.e == NE) ? u.pm : T.rowbase[u.e] + u.pm;
#pragma unroll
        for (int ai = 0; ai < 2; ++ai)
#pragma unroll
            for (int m = 0; m < 4; ++m) {
                const int r = 128 * ai + 64 * wr + 16 * m + fr;
                if (r < u.rows) {
                    v4u w;
#pragma unroll
                    for (int bj = 0; bj < 2; ++bj) { f32x4 v0 = acc[ai][bj][m][0], v1 = acc[ai][bj][m][1]; if (!FP8) { v0 *= YSCALE; v1 *= YSCALE; }
#pragma unroll
                        for (int j = 0; j < 4; ++j) { v0[j] = __builtin_amdgcn_fmed3f(v0[j], -F8MAX, F8MAX); v1[j] = __builtin_amdgcn_fmed3f(v1[j], -F8MAX, F8MAX); }
                        int w0 = __builtin_amdgcn_cvt_pk_fp8_f32(v0[0], v0[1], 0, false); w0 = __builtin_amdgcn_cvt_pk_fp8_f32(v0[2], v0[3], w0, true);
                        int w1 = __builtin_amdgcn_cvt_pk_fp8_f32(v1[0], v1[1], 0, false); w1 = __builtin_amdgcn_cvt_pk_fp8_f32(v1[2], v1[3], w1, true);
                        if (bj == 0) { w.x = (unsigned)w0; w.y = (unsigned)w1; } else { w.z = (unsigned)w0; w.w = (unsigned)w1; } }
                    __builtin_nontemporal_store(w, (v4u*)(yb + (size_t)(row0 + r) * D + cb));
                }
            }
    }
};

template <class P>
__device__ __forceinline__ void simple_gemm_phase(Frame& F, const P& p, int Geff = 0) {
    const int lane = F.lane, fr = lane & 15, fq = lane >> 4, w = F.wave;
    const int nu = p.nunits();
    const int G = Geff ? Geff : F.G, c0 = (P::RAW_BX ? (int)blockIdx.x : F.vcu);
    if (c0 >= G) return;
    for (int i = c0; i < nu; i += G) {
        Unit u; p.unit(i, u);
        f32x4 acc[2][16];
#pragma unroll
        for (int a = 0; a < 2; ++a)
#pragma unroll
            for (int n = 0; n < 16; ++n) acc[a][n] = (f32x4){0.f, 0.f, 0.f, 0.f};
        const bf16* ap[2]; ap[0] = p.arow(u, 32 * w + fr) + 8 * fq; ap[1] = p.arow(u, 32 * w + 16 + fr) + 8 * fq;
        const bf16* bp = p.brow(u, fr) + 8 * fq;
        for (int k0 = 0; k0 < P::K; k0 += 32) {
            const bf16x8 a0 = *(const bf16x8*)(ap[0] + k0), a1 = *(const bf16x8*)(ap[1] + k0);
#pragma unroll
            for (int n = 0; n < 16; ++n) {
                const bf16x8 b = *(const bf16x8*)(bp + (size_t)(16 * n) * P::K + k0);
                acc[0][n] = __builtin_amdgcn_mfma_f32_16x16x32_bf16(a0, b, acc[0][n], 0, 0, 0);
                acc[1][n] = __builtin_amdgcn_mfma_f32_16x16x32_bf16(a1, b, acc[1][n], 0, 0, 0);
            }
        }
#pragma unroll
        for (int a = 0; a < 2; ++a)
#pragma unroll
            for (int j = 0; j < 4; ++j) {
                const int r = 32 * w + 16 * a + 4 * fq + j;
                if constexpr (P::PAIR) {
#pragma unroll
                    for (int n = 0; n < 8; ++n) p.store2(u, r, 16 * n + fr, acc[a][n][j], acc[a][n + 8][j]);
                } else {
#pragma unroll
                    for (int n = 0; n < 16; ++n) p.store(u, r, 16 * n + fr, acc[a][n][j]);
                }
            }
    }
}
__device__ __forceinline__ void simple_gemm_out(Frame& F, const ProbOut& p) {
    const int lane = F.lane, fr = lane & 15, fq = lane >> 4, w = F.wave;
    for (int i = blockIdx.x; i < p.nunits(); i += F.G) {
        Unit u; p.unit(i, u);
        f32x4 acc[2][16];
#pragma unroll
        for (int a = 0; a < 2; ++a)
#pragma unroll
            for (int n = 0; n < 16; ++n) acc[a][n] = (f32x4){0.f, 0.f, 0.f, 0.f};
        const bf16* ap0 = p.arow(u, 32 * w + fr) + 8 * fq; const bf16* ap1 = p.arow(u, 32 * w + 16 + fr) + 8 * fq;
        const bf16* bp = p.brow(u, fr) + 8 * fq;
        for (int k0 = 0; k0 < D; k0 += 32) {
            const bf16x8 a0 = *(const bf16x8*)(ap0 + k0), a1 = *(const bf16x8*)(ap1 + k0);
#pragma unroll
            for (int n = 0; n < 16; ++n) {
                const bf16x8 b = *(const bf16x8*)(bp + (size_t)(16 * n) * D + k0);
                acc[0][n] = __builtin_amdgcn_mfma_f32_16x16x32_bf16(a0, b, acc[0][n], 0, 0, 0);
                acc[1][n] = __builtin_amdgcn_mfma_f32_16x16x32_bf16(a1, b, acc[1][n], 0, 0, 0);
            }
        }
#pragma unroll
        for (int a = 0; a < 2; ++a)
#pragma unroll
            for (int j = 0; j < 4; ++j) {
                const int row = u.pm * 256 + 32 * w + 16 * a + 4 * fq + j;
                float ss = 0.f;
#pragma unroll
                for (int n = 0; n < 16; ++n) { const int col = u.pn * 256 + 16 * n + fr; const float v = p.x[(size_t)row * D + col] + acc[a][n][j]; p.H1[(size_t)row * D + col] = (bf16)f2bf(v); ss += v * v; }
                ss += __shfl_xor(ss, 1); ss += __shfl_xor(ss, 2); ss += __shfl_xor(ss, 4); ss += __shfl_xor(ss, 8);
                if (fr == 0) atomicAdd(p.sumsq + row, ss);
            }
    }
}

namespace fg {
constexpr int BK = 64, HALF = 128, HTB = HALF * BK * 2;
#if LDS_LINES
__device__ __forceinline__ int lds_byte(int r, int c) { const int ch = (c >> 3) ^ (((r >> 1) & 1) << 2); return (r >> 3) * 1024 + (r & 7) * 128 + (ch << 4) + (c & 7) * 2; }
__device__ __forceinline__ void stage_rc(int b, int& R, int& C) { const int blk = b >> 10, w = b & 1023; R = blk * 8 + (w >> 7); C = ((((w >> 4) & 7) ^ (((R >> 1) & 1) << 2)) << 3); }
#else
__device__ __forceinline__ int lds_byte(int r, int c) { const int st = (r >> 4) * 2 + (c >> 5), rr = r & 15, cc = c & 31, ob = rr * 64 + cc * 2; return st * 1024 + (ob ^ (((ob >> 9) & 1) << 5)); }
__device__ __forceinline__ void stage_rc(int b, int& R, int& C) { const int st = b / 1024, sb = b % 1024, swz = sb ^ (((sb >> 9) & 1) << 5); R = (st >> 1) * 16 + swz / 64; C = (st & 1) * 32 + (swz % 64) / 2; }
#endif
__device__ __forceinline__ int perm32(int rho) { const int n = rho >> 4, i = rho & 15; return 8 * (i >> 2) + 4 * n + (i & 3); }

typedef int v8i __attribute__((ext_vector_type(8)));
typedef int v4i __attribute__((ext_vector_type(4)));
__device__ __forceinline__ const char* uptr(const char* p) { const unsigned long long v = (unsigned long long)p; const unsigned lo = __builtin_amdgcn_readfirstlane((unsigned)v), hi = __builtin_amdgcn_readfirstlane((unsigned)(v >> 32)); return (const char*)(((unsigned long long)hi << 32) | lo); }
template <class P>
__device__ __forceinline__ void gemm_phase(Frame& F, const P& p, int Geff = 0) {
    constexpr int K = P::K, nt = K / BK;
    LAS unsigned char* lds = F.lds;
    const int tid = F.tid, wid = F.wave, lane = F.lane, wr = wid >> 2, wc = wid & 3, fr = lane & 15, fq = lane >> 4;
    const int nu = p.nunits(), c0 = P::RAW_BX ? (int)blockIdx.x : F.vcu, G = Geff ? Geff : F.G;
    if (c0 >= nu || c0 >= G) return;
    unsigned voffB[2][2];
#pragma unroll
    for (int i = 0; i < 2; ++i) { int R, C; stage_rc(tid * 16 + i * 8192, R, C);
#pragma unroll
        for (int bj = 0; bj < 2; ++bj) voffB[bj][i] = (unsigned)(P::bcol(bj, R) * K + C) * 2u; }
    constexpr size_t kstep = (size_t)(BK * 2);
    const unsigned ldsw = (unsigned)wid * 1024u;
    const int aoff = lds_byte(wr * 64 + fr, fq * 8), boff = lds_byte(wc * 32 + fr, fq * 8);
    const int aoffh = LDS_LINES ? (aoff ^ 64) : aoff + 1024, boffh = LDS_LINES ? (boff ^ 64) : boff + 1024;
#define FG_SA(b, h) (((b) * 2 + (h)) * HTB)
#define FG_SB(b, h) ((4 + (b) * 2 + (h)) * HTB)
#define FG_STAGE(bufoff, gbase, voff) do { _Pragma("unroll") for (int _i = 0; _i < 2; ++_i) { unsigned _v = (voff)[_i]; asm volatile("" : "+v"(_v));     \
        __builtin_amdgcn_global_load_lds((const unsigned*)((const char*)(gbase) + _v), (LAS unsigned*)(lds + (bufoff) + ldsw + _i * 8192), 16, 0, 0); } } while (0)
#define FG_LDA(dst, b, h) do { _Pragma("unroll") for (int m = 0; m < 4; ++m) { dst[m].lo = *(const LAS v4i*)(lds + FG_SA(b, h) + aoff + m * 2048); dst[m].hi = *(const LAS v4i*)(lds + FG_SA(b, h) + aoffh + m * 2048); } } while (0)
#define FG_LDB(dst, b, h) do { _Pragma("unroll") for (int n = 0; n < 2; ++n) { dst[n].lo = *(const LAS v4i*)(lds + FG_SB(b, h) + boff + n * 2048); dst[n].hi = *(const LAS v4i*)(lds + FG_SB(b, h) + boffh + n * 2048); } } while (0)
#define FG_MMA(ai, bj, At, Bt) do { __builtin_amdgcn_s_setprio(1); _Pragma("unroll") for (int m = 0; m < 4; ++m) _Pragma("unroll") for (int n = 0; n < 2; ++n) { \
        if constexpr (P::FP8) acc[ai][bj][m][n] = __builtin_amdgcn_mfma_scale_f32_16x16x128_f8f6f4(Bt[n], At[m], acc[ai][bj][m][n], 0, 0, 0, P::MSCALE, 0, 127); \
        else { acc[ai][bj][m][n] = __builtin_amdgcn_mfma_f32_16x16x32_bf16(__builtin_bit_cast(bf16x8, (v4i)Bt[n].lo), __builtin_bit_cast(bf16x8, (v4i)At[m].lo), acc[ai][bj][m][n], 0, 0, 0); \
               acc[ai][bj][m][n] = __builtin_amdgcn_mfma_f32_16x16x32_bf16(__builtin_bit_cast(bf16x8, (v4i)Bt[n].hi), __builtin_bit_cast(bf16x8, (v4i)At[m].hi), acc[ai][bj][m][n], 0, 0, 0); } } __builtin_amdgcn_s_setprio(0); } while (0)
#define FG_WAIT_V(n) asm volatile("s_waitcnt vmcnt(" #n ")" ::: "memory")
#define FG_WAIT_L(n) asm volatile("s_waitcnt lgkmcnt(" #n ")" ::: "memory")
#define FG_BAR __builtin_amdgcn_s_barrier()
#define FG_SCHED __builtin_amdgcn_sched_barrier(0)
#define FG_AOFFS(dst, u, slot) do { int _t = tid; asm volatile("" : "+v"(_t)); _Pragma("unroll") for (int _i = 0; _i < 2; ++_i) { int _R, _C; stage_rc(_t * 16 + _i * 8192, _R, _C); \
        _Pragma("unroll") for (int _h = 0; _h < 2; ++_h) dst[_h][_i] = p.aoff(u, slot, 128 * _h + _R, _C); } } while (0)
    Unit cur, nxt; int ui = 0;
    p.unit(c0, cur, 0);
    cur.pm = __builtin_amdgcn_readfirstlane(cur.pm); cur.pn = __builtin_amdgcn_readfirstlane(cur.pn); cur.e = __builtin_amdgcn_readfirstlane(cur.e); cur.rows = __builtin_amdgcn_readfirstlane(cur.rows);
    unsigned cvo[2][2];
    FG_AOFFS(cvo, cur, 0);
    AccT acc;
#pragma unroll
    for (int a = 0; a < 2; ++a)
#pragma unroll
        for (int b = 0; b < 2; ++b)
#pragma unroll
            for (int m = 0; m < 4; ++m)
#pragma unroll
                for (int n = 0; n < 2; ++n) acc[a][b][m][n] = (f32x4){0.f, 0.f, 0.f, 0.f};
    v8i At[4], B0[2], B1[2];
    const char* const Ab = p.abase();
    const char* cB = p.bbase(cur);
    FG_STAGE(FG_SB(0, 0), cB, voffB[0]); FG_STAGE(FG_SB(0, 1), cB, voffB[1]); FG_STAGE(FG_SA(0, 0), Ab, cvo[0]); FG_STAGE(FG_SA(0, 1), Ab, cvo[1]);
    if (wr == 1) FG_BAR;
    FG_WAIT_V(2); FG_BAR;
    FG_STAGE(FG_SB(1, 0), cB + kstep, voffB[0]); FG_STAGE(FG_SA(1, 0), Ab + kstep, cvo[0]); FG_STAGE(FG_SB(1, 1), cB + kstep, voffB[1]);
    FG_WAIT_V(6); FG_BAR;
    for (;;) {
        const int nidx = c0 + (ui + 1) * G;
        const bool has_next = nidx < nu;
        const char* nB = cB;
        if (has_next) {
            p.unit(nidx, nxt, ui + 1);
            nxt.pm = __builtin_amdgcn_readfirstlane(nxt.pm); nxt.pn = __builtin_amdgcn_readfirstlane(nxt.pn); nxt.e = __builtin_amdgcn_readfirstlane(nxt.e); nxt.rows = __builtin_amdgcn_readfirstlane(nxt.rows);
            nB = p.bbase(nxt);
        }
#pragma unroll 1
        for (int t = 0; t < nt; t += 2) {
            const bool last = (t == nt - 2);
            const char* a1 = uptr(Ab + (size_t)(t + 1) * kstep);
            const char* a2 = uptr(last ? Ab : Ab + (size_t)(t + 2) * kstep); const char* b2 = uptr(last ? nB : cB + (size_t)(t + 2) * kstep);
            const char* a3 = uptr(a2 + kstep); const char* b3 = uptr(b2 + kstep);
            FG_LDB(B0, 0, 0); FG_LDB(B1, 0, 1); FG_SCHED; FG_LDA(At, 0, 0); FG_STAGE(FG_SA(1, 1), a1, cvo[1]);
            if (last && has_next) FG_AOFFS(cvo, nxt, ui + 1);
            FG_WAIT_V(8); FG_WAIT_L(0); FG_BAR; FG_MMA(0, 0, At, B0); FG_MMA(0, 1, At, B1); FG_BAR; FG_SCHED;
            FG_LDA(At, 0, 1); FG_STAGE(FG_SB(0, 0), b2, voffB[0]); FG_STAGE(FG_SB(0, 1), b2, voffB[1]); FG_STAGE(FG_SA(0, 0), a2, cvo[0]);
            FG_WAIT_V(8); FG_WAIT_L(0); FG_BAR; FG_MMA(1, 0, At, B0); FG_MMA(1, 1, At, B1); FG_BAR; FG_SCHED;
            FG_LDB(B0, 1, 0); FG_LDB(B1, 1, 1); FG_SCHED; FG_LDA(At, 1, 0); FG_STAGE(FG_SA(0, 1), a2, cvo[1]);
            FG_WAIT_V(8); FG_WAIT_L(0); FG_BAR; FG_MMA(0, 0, At, B0); FG_MMA(0, 1, At, B1); FG_BAR; FG_SCHED;
            FG_LDA(At, 1, 1); FG_STAGE(FG_SB(1, 0), b3, voffB[0]); FG_STAGE(FG_SB(1, 1), b3, voffB[1]); FG_STAGE(FG_SA(1, 0), a3, cvo[0]);
            FG_WAIT_V(8); FG_WAIT_L(0); FG_BAR; FG_MMA(1, 0, At, B0); FG_MMA(1, 1, At, B1); FG_BAR; FG_SCHED;
        }
        if (wr == 0) FG_BAR;
        { int lne = lane; asm volatile("" : "+v"(lne));
          p.epi(acc, cur, wr, wc, lne & 15, lne >> 4); }
        if (!has_next) break;
#pragma unroll
        for (int a = 0; a < 2; ++a)
#pragma unroll
            for (int b = 0; b < 2; ++b)
#pragma unroll
                for (int m = 0; m < 4; ++m)
#pragma unroll
                    for (int n = 0; n < 2; ++n) acc[a][b][m][n] = (f32x4){0.f, 0.f, 0.f, 0.f};
        cur = nxt; cB = nB; ++ui;
        if (wr == 1) FG_BAR;
    }
    FG_WAIT_V(0);
    FG_BAR;
#undef FG_SA
#undef FG_SB
#undef FG_STAGE
#undef FG_LDA
#undef FG_LDB
#undef FG_MMA
#undef FG_WAIT_V
#undef FG_WAIT_L
#undef FG_BAR
#undef FG_SCHED
#undef FG_AOFFS
}
}
namespace e2 {
typedef int v8i __attribute__((ext_vector_type(8)));
typedef int v4i __attribute__((ext_vector_type(4)));
__device__ __forceinline__ int sw(int row, int chunk) { return row * 256 + ((chunk ^ (row & 15)) << 4); }
struct Tile { int e, pm, rows; };
__device__ __forceinline__ void tile_of(const MoeTab& T, int tr, Tile& t) { Unit u; moe_tile(T, 128 + tr, u); t.e = __builtin_amdgcn_readfirstlane(u.e); t.pm = __builtin_amdgcn_readfirstlane(u.pm); t.rows = __builtin_amdgcn_readfirstlane(u.rows); }
__device__ __forceinline__ void load_a(v8i (&a)[2][2], const unsigned char* HIDq, const MoeTab& T, const Tile& t, int w, int lane) {
    const int fr = lane & 15, fq = lane >> 4; const char* base = fg::uptr((const char*)HIDq + (size_t)(NTOK + T.rowbase[t.e] + t.pm) * 256);
#pragma unroll
    for (int mt = 0; mt < 2; ++mt)
#pragma unroll
        for (int ks = 0; ks < 2; ++ks) { unsigned o = (unsigned)((32 * w + 16 * mt + fr) * 256 + 16 * (8 * ks + fq)); asm volatile("" : "+v"(o));
            a[mt][ks].lo = *(const v4i*)(base + o); a[mt][ks].hi = *(const v4i*)(base + o + 64); }
}
__device__ __forceinline__ void phase(Frame& F, const MoeTab& T, const unsigned char* HIDq, const unsigned char* WD8, unsigned char* YR, unsigned char* dump) {
    LAS unsigned char* L = F.lds; const int lane = F.lane, w = F.wave;
    const int ntr = T.tb[NE];
    if (F.vcu >= ntr) return;
    const int ntl = (ntr - F.vcu + F.G - 1) / F.G, nh = 8 * ntl;
    Tile cur, nxt; tile_of(T, F.vcu, cur); nxt = cur;
#define E2_STAGE_B(g, te) do { const int _hf = (g) & 7; const char* _bb = fg::uptr((const char*)WD8 + (size_t)(te) * D * 256); const int _rg = ln >> 4, _pc = ln & 15; \
        _Pragma("unroll") for (int i = 0; i < 4; ++i) { const int s = 16 * w + 4 * i + _rg, col = 32 * ((s & 15) >> 2) + 4 * (s >> 4) + (s & 3); \
            unsigned bo = (unsigned)((128 * _hf + col) * 256 + 16 * (_pc ^ (s & 15))); asm volatile("" : "+v"(bo)); \
            __builtin_amdgcn_global_load_lds((const unsigned*)(_bb + bo), (LAS unsigned*)(L + ((g) & 3) * 32768 + (16 * w + 4 * i) * 256), 16, 0, 0); } } while (0)
    v8i a[2][2], a2[2][2];
    { int ln = lane; asm volatile("" : "+v"(ln));
      E2_STAGE_B(0, cur.e); E2_STAGE_B(1, cur.e); E2_STAGE_B(2, cur.e); }
    load_a(a, HIDq, T, cur, w, lane);
#pragma unroll
    for (int mt = 0; mt < 2; ++mt)
#pragma unroll
        for (int ks = 0; ks < 2; ++ks) a2[mt][ks] = a[mt][ks];
    asm volatile("s_waitcnt vmcnt(0)" ::: "memory");
#pragma unroll 1
    for (int g = 0; g < nh; ++g) {
        int ln = lane; asm volatile("" : "+v"(ln)); const int fr = ln & 15, fq = ln >> 4;
        const int hf = g & 7;
        if (g + 3 > nh) asm volatile("s_waitcnt vmcnt(0)" ::: "memory"); else asm volatile("s_waitcnt vmcnt(20)" ::: "memory");
        WG_BARRIER();
        if (hf == 0 && g > 0) { cur = nxt; }
        if (hf == 4) { const int k1 = (g >> 3) + 1; if (k1 < ntl) tile_of(T, F.vcu + k1 * F.G, nxt); }
        if (g + 3 < nh) { const int te = ((g + 3) >> 3) == (g >> 3) ? cur.e : nxt.e; E2_STAGE_B(g + 3, te); }
        else {
            E2_STAGE_B(g + 3, cur.e); }
        if (hf == 5 && (g >> 3) + 1 < ntl) load_a(a2, HIDq, T, nxt, w, ln);
        f32x4 acc[2][8];
#pragma unroll
        for (int mt = 0; mt < 2; ++mt)
#pragma unroll
            for (int nt = 0; nt < 8; ++nt) acc[mt][nt] = (f32x4){0.f, 0.f, 0.f, 0.f};
        const LAS unsigned char* Bq = L + (g & 3) * 32768;
#pragma unroll
        for (int ks = 0; ks < 2; ++ks)
#pragma unroll
            for (int nt = 0; nt < 8; ++nt) {
                v8i b; b.lo = *(const LAS v4i*)(Bq + sw(16 * nt + fr, 8 * ks + fq)); b.hi = *(const LAS v4i*)(Bq + sw(16 * nt + fr, 8 * ks + 4 + fq));
                acc[0][nt] = __builtin_amdgcn_mfma_scale_f32_16x16x128_f8f6f4(b, a[0][ks], acc[0][nt], 0, 0, 0, 127, 0, 127);
                acc[1][nt] = __builtin_amdgcn_mfma_scale_f32_16x16x128_f8f6f4(b, a[1][ks], acc[1][nt], 0, 0, 0, 127, 0, 127);
            }
        constexpr float dq = YSCALE / (HQ_SCALE * WDQ_SCALE);
#pragma unroll
        for (int mt = 0; mt < 2; ++mt) {
            const int r = 32 * w + 16 * mt + fr;
            unsigned char* p = (r < cur.rows) ? YR + (size_t)(T.rowbase[cur.e] + cur.pm + r) * D + 128 * hf + 32 * fq : dump + (size_t)F.tid * 32;
#pragma unroll
            for (int q = 0; q < 2; ++q) { unsigned wd[4];
#pragma unroll
                for (int x = 0; x < 4; ++x) { const f32x4 v = acc[mt][4 * q + x] * dq; int t = __builtin_amdgcn_cvt_pk_fp8_f32(v[0], v[1], 0, false); t = __builtin_amdgcn_cvt_pk_fp8_f32(v[2], v[3], t, true); wd[x] = (unsigned)t; }
                *(v4u*)(p + 16 * q) = (v4u){wd[0], wd[1], wd[2], wd[3]}; }
        }
        if (hf == 7) {
#pragma unroll
            for (int mt = 0; mt < 2; ++mt)
#pragma unroll
                for (int ks = 0; ks < 2; ++ks) a[mt][ks] = a2[mt][ks];
        }
    }
#undef E2_STAGE_B
    asm volatile("s_waitcnt vmcnt(0)" ::: "memory");
    WG_BARRIER();
}
}

template <class P>
__device__ __forceinline__ void moe_fill_units(Frame& F, P& p, LAS int* ut) {
    const int nu = p.nunits(), slot = F.tid, i = F.vcu + slot * F.G;
    if (i < nu) { Unit u; p.unit(i, u); ut[4 * slot] = u.e; ut[4 * slot + 1] = u.pm; ut[4 * slot + 2] = u.rows; ut[4 * slot + 3] = u.pn; }
    __syncthreads();
    p.ut = ut;
}
__device__ __forceinline__ void e1_fill_idx(Frame& F, const ProbE1& p) {
    const int nu = p.nunits(), G = F.G;
    int tv[11];
#pragma unroll
    for (int slot = 0; slot < 11; ++slot) { const int i = F.vcu + slot * G; tv[slot] = 0;
        if (i < nu && F.tid < 256) { Unit u; p.unit(i, u, slot); tv[slot] = p.token(u, F.tid); } }
#pragma unroll
    for (int slot = 0; slot < 11; ++slot) { const int i = F.vcu + slot * G; if (i < nu && F.tid < 256) p.idx[slot * 256 + F.tid] = tv[slot]; }
    __syncthreads();
}

__device__ __forceinline__ void hgrn_naive(Frame& F) {
    const bf16* PROJ = (const bf16*)(F.ws + WS_PROJ); const float* LB = (const float*)(F.ws + WS_LB); float* ORAW = (float*)(F.ws + WS_ORAW);
    LAS float* qs = (LAS float*)F.lds; LAS float* fs = qs + 2 * 512; LAS float* ks = fs + 2 * 512;
    const int tid = F.tid, h = tid >> 7;
    for (int b = F.vcu; b < NB; b += F.G) {
        float S[128];
#pragma unroll
        for (int d = 0; d < 128; ++d) S[d] = 0.f;
        const float lb = LB[tid];
        for (int t = 0; t < NMETA + SEQ; ++t) {
            const size_t row = (t < NMETA) ? (size_t)(NTOK + t) : (size_t)b * SEQ + (t - NMETA);
            const bf16* pr = PROJ + row * PW;
            const int buf = (t & 1) * 512;
            const float q = bf2f(pr[tid]), z = bf2f(pr[512 + tid]), iv = bf2f(pr[1024 + tid]);
            const float f = lb + (1.f - lb) * sigmoidf_(z);
            qs[buf + tid] = q; fs[buf + tid] = f; ks[buf + tid] = (1.f - lb) * sigmoidf_(-z);
            __syncthreads();
            float o = 0.f;
            const LAS f32x4* q4 = (const LAS f32x4*)(qs + buf + h * 128); const LAS f32x4* f4 = (const LAS f32x4*)(fs + buf + h * 128); const LAS f32x4* k4 = (const LAS f32x4*)(ks + buf + h * 128);
#pragma unroll
            for (int d4 = 0; d4 < 32; ++d4) {
                const f32x4 qq = q4[d4], ff = f4[d4], kk = k4[d4];
#pragma unroll
                for (int j = 0; j < 4; ++j) { S[4 * d4 + j] = ff[j] * S[4 * d4 + j] + kk[j] * iv; o += qq[j] * S[4 * d4 + j]; }
            }
            if (t >= NMETA) ORAW[row * HW + tid] = o;
        }
        __syncthreads();
    }
}

namespace hg {
constexpr int BF_OFF = 0, TOT_OFF = 32768, BMID_OFF = 34816, BLAST_OFF = 35328, QT_OFF = 36864, KT_OFF = 53248, QH_OFF = 69632, VT_OFF = 86016, PP_OFF = 102400, OI_OFF = QT_OFF, CONST_OFF = 110592;
typedef short v4i16_t __attribute__((ext_vector_type(4)));
__device__ __forceinline__ int offb(int row, int ch) { return 256 * row + 16 * (ch ^ (((row & 3) << 2) | ((row >> 2) & 3))); }
__device__ __forceinline__ int off8(int row, int chunk) { return row * 128 + ((chunk ^ (row & 7)) << 4); }
__device__ __forceinline__ void unpack8(const v4u& w, float (&f)[8]) { f[0] = bflo(w.x); f[1] = bfhi(w.x); f[2] = bflo(w.y); f[3] = bfhi(w.y); f[4] = bflo(w.z); f[5] = bfhi(w.z); f[6] = bflo(w.w); f[7] = bfhi(w.w); }
__device__ __forceinline__ bf16x8 rowfrag(const LAS unsigned char* img, int lane, int rb, int s) { return *(const LAS bf16x8*)(img + offb((lane & 15) + 16 * rb, 4 * s + (lane >> 4))); }
__device__ __forceinline__ bf16x8 trfrag(const LAS unsigned char* img, int lane, int c, int ks) {
    const int g = lane >> 4, q = (lane & 15) >> 2, p = lane & 3;
    const v4i16_t lo = __builtin_amdgcn_ds_read_tr16_b64_v4i16((LAS v4i16_t*)(img + offb(32 * ks + 8 * g + q, 2 * c + (p >> 1)) + 8 * (p & 1)));
    const v4i16_t hi = __builtin_amdgcn_ds_read_tr16_b64_v4i16((LAS v4i16_t*)(img + offb(32 * ks + 8 * g + 4 + q, 2 * c + (p >> 1)) + 8 * (p & 1)));
    return (bf16x8){lo[0], lo[1], lo[2], lo[3], hi[0], hi[1], hi[2], hi[3]};
}
struct Chunks { v4u z[2], q[2], v[2]; };
template <bool WANT_Q, bool WANT_V = true, bool NT = false>
__device__ __forceinline__ void load_chunks(Chunks& c, const bf16* PROJ, size_t row0, int h, int nvalid, int tid) {
    const int cc = tid & 15; const char* base = (const char*)PROJ;
#pragma unroll
    for (int jj = 0; jj < 2; ++jj) {
        const int s = (tid >> 4) + 32 * jj; const unsigned o = (unsigned)(((unsigned)row0 + (unsigned)s) * (unsigned)PW + (unsigned)(h * 128 + 8 * cc)) * 2u;
        if (s < nvalid) { c.z[jj] = NT ? __builtin_nontemporal_load((const v4u*)(base + o + 1024)) : *(const v4u*)(base + o + 1024); if (WANT_V) c.v[jj] = *(const v4u*)(base + o + 2048);
            if (WANT_Q) c.q[jj] = NT ? __builtin_nontemporal_load((const v4u*)(base + o)) : *(const v4u*)(base + o); else c.q[jj] = (v4u){0u, 0u, 0u, 0u}; }
        else { c.z[jj] = (v4u){0u, 0u, 0u, 0u}; if (WANT_V) c.v[jj] = (v4u){0u, 0u, 0u, 0u}; c.q[jj] = (v4u){0u, 0u, 0u, 0u}; }
    }
}
template <bool WANT_Q>
__device__ __forceinline__ void prep(Frame& F, const Chunks& c, const float* LB, int h, int nvalid, int tid_ = -1) {
    LAS unsigned char* L = F.lds; const int tid = tid_ >= 0 ? tid_ : F.tid;
    LAS float* BF = (LAS float*)(L + BF_OFF); LAS float* TOT = (LAS float*)(L + TOT_OFF); LAS float* BMID = (LAS float*)(L + BMID_OFF); LAS float* BLAST = (LAS float*)(L + BLAST_OFF);
    const int cc = tid & 15;
    float lb[8]; { const f32x4 a = *(const f32x4*)(LB + h * 128 + 8 * cc), b = *(const f32x4*)(LB + h * 128 + 8 * cc + 4); lb[0] = a.x; lb[1] = a.y; lb[2] = a.z; lb[3] = a.w; lb[4] = b.x; lb[5] = b.y; lb[6] = b.z; lb[7] = b.w; }
    float kreg[2][8];
#pragma unroll
    for (int jj = 0; jj < 2; ++jj) {
        if (jj == 1) __builtin_amdgcn_sched_barrier(0);
        const int s = (tid >> 4) + 32 * jj; float z[8]; unpack8(c.z[jj], z); f32x4 o0, o1;
#pragma unroll
        for (int e = 0; e < 8; ++e) { const float f = lb[e] + (1.f - lb[e]) * sigmoidf_(z[e]); const float lf = (s < nvalid) ? flog_(f) : 0.f; kreg[jj][e] = (s < nvalid) ? 1.f - f : 0.f; if (e < 4) o0[e] = lf; else o1[e - 4] = lf; }
        *(LAS f32x4*)(BF + s * 128 + 8 * cc) = o0; *(LAS f32x4*)(BF + s * 128 + 8 * cc + 4) = o1;
    }
    WG_BARRIER();
    {
        const int d = tid & 127, seg = tid >> 7; float run = 0.f;
#pragma unroll
        for (int i = 0; i < 16; ++i) run += BF[(16 * seg + i) * 128 + d];
        TOT[seg * 128 + d] = run;
        WG_BARRIER();
        const float t0 = TOT[d], t1 = TOT[128 + d], t2 = TOT[256 + d], t3 = TOT[384 + d];
        run = (seg > 0 ? t0 : 0.f) + (seg > 1 ? t1 : 0.f) + (seg > 2 ? t2 : 0.f);
#pragma unroll
        for (int i = 0; i < 16; ++i) { run += BF[(16 * seg + i) * 128 + d]; BF[(16 * seg + i) * 128 + d] = run; }
        if (seg == 0) { BMID[d] = t0 + t1; BLAST[d] = (t0 + t1) + (t2 + t3); }
    }
    WG_BARRIER();
    float bm[8]; { const f32x4 a = *(const LAS f32x4*)(BMID + 8 * cc), b = *(const LAS f32x4*)(BMID + 8 * cc + 4); bm[0] = a.x; bm[1] = a.y; bm[2] = a.z; bm[3] = a.w; bm[4] = b.x; bm[5] = b.y; bm[6] = b.z; bm[7] = b.w; }
#pragma unroll
    for (int jj = 0; jj < 2; ++jj) {
        const int s = (tid >> 4) + 32 * jj;
        float q[8], bb[8]; unpack8(c.q[jj], q);
        { const f32x4 a = *(const LAS f32x4*)(BF + s * 128 + 8 * cc), b = *(const LAS f32x4*)(BF + s * 128 + 8 * cc + 4); bb[0] = a.x; bb[1] = a.y; bb[2] = a.z; bb[3] = a.w; bb[4] = b.x; bb[5] = b.y; bb[6] = b.z; bb[7] = b.w; }
        float kt[8], qt[8], qh[8];
#pragma unroll
        for (int e = 0; e < 8; ++e) {
            const float E = fexp_(bm[e] - bb[e]);
            kt[e] = kreg[jj][e] * E;
            if (WANT_Q) { qt[e] = q[e] * rcpf_(E); qh[e] = q[e] * fexp_(bb[e]); }
        }
        *(LAS v4u*)(L + KT_OFF + offb(s, cc)) = (v4u){pk2(kt[0], kt[1]), pk2(kt[2], kt[3]), pk2(kt[4], kt[5]), pk2(kt[6], kt[7])};
        if (WANT_Q) {
            *(LAS v4u*)(L + QT_OFF + offb(s, cc)) = (v4u){pk2(qt[0], qt[1]), pk2(qt[2], qt[3]), pk2(qt[4], qt[5]), pk2(qt[6], qt[7])};
            *(LAS v4u*)(L + QH_OFF + offb(s, cc)) = (v4u){pk2(qh[0], qh[1]), pk2(qh[2], qh[3]), pk2(qh[4], qh[5]), pk2(qh[6], qh[7])};
        }
        *(LAS v4u*)(L + VT_OFF + offb(s, cc)) = c.v[jj];
    }
    WG_BARRIER();
}

__device__ __forceinline__ void pa_item(int it, int& h, int& nvalid, size_t& row0) {
    if (it < 16 * 127) { const int bh = it / 127, c = it % 127; h = bh & 3; row0 = (size_t)(bh >> 2) * SEQ + 64 * c; nvalid = 64; }
    else { h = it - 16 * 127; row0 = NTOK; nvalid = NMETA; }
}
__device__ __forceinline__ void pass_a(Frame& F) {
    const bf16* PROJ = (const bf16*)(F.ws + WS_PROJ); const float* LB = (const float*)(F.ws + WS_LB);
    bf16* DS = (bf16*)(F.ws + WS_DS); bf16* DSM = (bf16*)(F.ws + WS_DSM); float* DD = (float*)(F.ws + WS_DD);
    LAS unsigned char* L = F.lds; const int lane = F.lane, fr = lane & 15, fq = lane >> 4, w = F.wave;
    constexpr int NITEMS = 16 * 127 + 4;
    if (F.vcu >= NITEMS) return;
    Chunks ch; { int h, nv; size_t r0; pa_item(F.vcu, h, nv, r0); load_chunks<false>(ch, PROJ, r0, h, nv, F.tid); }
    for (int it = F.vcu; it < NITEMS; it += F.G) {
        int h, nvalid; size_t row0; pa_item(it, h, nvalid, row0);
        bf16* dst; float* ddst = nullptr;
        if (it < 16 * 127) { const int bh = it / 127, c = it % 127; dst = DS + (size_t)(bh * 128 + c) * 16384; ddst = DD + (size_t)(bh * 128 + c) * 128; } else dst = DSM + (size_t)h * 16384;
        prep<false>(F, ch, LB, h, nvalid);
        if (it + F.G < NITEMS) { int h2, nv2; size_t r2; pa_item(it + F.G, h2, nv2, r2); load_chunks<false>(ch, PROJ, r2, h2, nv2, F.tid); }
        f32x4 acc[8];
#pragma unroll
        for (int n = 0; n < 8; ++n) acc[n] = (f32x4){0.f, 0.f, 0.f, 0.f};
#pragma unroll
        for (int kk = 0; kk < 2; ++kk) {
            const bf16x8 a = trfrag(L + KT_OFF, lane, w, kk);
#pragma unroll
            for (int n = 0; n < 8; ++n) { const bf16x8 b = trfrag(L + VT_OFF, lane, n, kk); acc[n] = __builtin_amdgcn_mfma_f32_16x16x32_bf16(a, b, acc[n], 0, 0, 0); }
        }
        const LAS float* BMID = (const LAS float*)(L + BMID_OFF); const LAS float* BLAST = (const LAS float*)(L + BLAST_OFF);
        float sc[4];
#pragma unroll
        for (int j = 0; j < 4; ++j) { const int d = 16 * w + 4 * fq + j; sc[j] = fexp_(BLAST[d] - BMID[d]); }
#pragma unroll
        for (int n = 0; n < 8; ++n) { const int v = 16 * n + fr; *(v2u*)(dst + (size_t)v * 128 + 16 * w + 4 * fq) = (v2u){pk2(acc[n][0] * sc[0], acc[n][1] * sc[1]), pk2(acc[n][2] * sc[2], acc[n][3] * sc[3])}; }
        if (ddst && F.tid < 128) ddst[F.tid] = fexp_(BLAST[F.tid]);
        WG_BARRIER();
    }
}
__device__ __forceinline__ void scan_phase(Frame& F) {
    const bf16* DS = (const bf16*)(F.ws + WS_DS); const bf16* DSM = (const bf16*)(F.ws + WS_DSM); const float* DD = (const float*)(F.ws + WS_DD); bf16* SS = (bf16*)(F.ws + WS_SS);
    for (int t = F.vcu * NTHREADS + F.tid; t < 16 * 8192; t += F.G * NTHREADS) {
        const int bh = t >> 13, rem = t & 8191, v = rem >> 6, d = 2 * (rem & 63), h = bh & 3;
        const unsigned m = *(const unsigned*)(DSM + (size_t)h * 16384 + v * 128 + d);
        float s0 = bflo(m), s1 = bfhi(m);
        const size_t base = (size_t)bh * 128 * 16384 + (size_t)v * 128 + d;
        *(unsigned*)(SS + base) = m;
        const bf16* dsp = DS + base; const float* ddp = DD + (size_t)bh * 128 * 128 + d; bf16* ssp = SS + base + 16384;
        for (int c0 = 0; c0 < 127; c0 += 16) {
            unsigned ds[16]; f32x2 dd[16];
#pragma unroll
            for (int i = 0; i < 16; ++i) { const int c = (c0 + i < 127) ? c0 + i : 126; ds[i] = *(const unsigned*)(dsp + (size_t)c * 16384); dd[i] = *(const f32x2*)(ddp + (size_t)c * 128); }
#pragma unroll
            for (int i = 0; i < 16; ++i) if (c0 + i < 127) { s0 = dd[i].x * s0 + bflo(ds[i]); s1 = dd[i].y * s1 + bfhi(ds[i]); *(unsigned*)(ssp + (size_t)(c0 + i) * 16384) = pk2(s0, s1); }
        }
    }
}
__device__ __forceinline__ void pass_c(Frame& F) {
    const bf16* PROJ = (const bf16*)(F.ws + WS_PROJ); const float* LB = (const float*)(F.ws + WS_LB); const bf16* SS = (const bf16*)(F.ws + WS_SS); bf16* Y = (bf16*)(F.ws + WS_Y);
    const float* hg_ = F.in[5]; const float* cw = F.in[6]; const float* cg = F.in[7];
    LAS unsigned char* L = F.lds; const int tid = F.tid, lane = F.lane, fr = lane & 15, fq = lane >> 4, w = F.wave, cc = tid & 15;
    constexpr int NITEMS = 16 * 128;
    if (F.vcu >= NITEMS) return;
    Chunks ch; v4u st[4];
    { const int it = F.vcu, bh = it >> 7, c = it & 127; load_chunks<true>(ch, PROJ, (size_t)(bh >> 2) * SEQ + 64 * c, bh & 3, 64, tid);
      const bf16* sp = SS + (size_t)it * 16384;
#pragma unroll
      for (int i = 0; i < 4; ++i) st[i] = *(const v4u*)(sp + (size_t)(tid + 512 * i) * 8); }
    for (int it = F.vcu; it < NITEMS; it += F.G) {
        const int bh = it >> 7, c = it & 127, b = bh >> 2, h = bh & 3; const size_t row0 = (size_t)b * SEQ + 64 * c;
        prep<true>(F, ch, LB, h, 64);
#pragma unroll
        for (int i = 0; i < 4; ++i) { const int ci = tid + 512 * i; *(LAS v4u*)(L + BF_OFF + offb(ci >> 4, ci & 15)) = st[i]; }
        if (it + F.G < NITEMS) { const int it2 = it + F.G, bh2 = it2 >> 7, c2 = it2 & 127; load_chunks<true>(ch, PROJ, (size_t)(bh2 >> 2) * SEQ + 64 * c2, bh2 & 3, 64, tid);
            const bf16* sp = SS + (size_t)it2 * 16384;
#pragma unroll
            for (int i = 0; i < 4; ++i) st[i] = *(const v4u*)(sp + (size_t)(tid + 512 * i) * 8); }
        v4u eg[2], eb[2], ec0[2], ev0[2], ec1[2], ev1[2], ec2[2], ev2[2];
#pragma unroll
        for (int jj = 0; jj < 2; ++jj) {
            const int s = (tid >> 4) + 32 * jj, t = 64 * c + s; const bf16* pr = PROJ + (row0 + s) * PW + h * 128 + 8 * cc;
            const bf16* p1 = (t >= 1) ? pr - PW : PROJ + (size_t)(NTOK + 15) * PW + h * 128 + 8 * cc;
            const bf16* p2 = (t >= 2) ? pr - 2 * PW : PROJ + (size_t)(NTOK + 14 + t) * PW + h * 128 + 8 * cc;
            eg[jj] = *(const v4u*)(pr + 1536); eb[jj] = *(const v4u*)(pr + 2048); ec0[jj] = *(const v4u*)(pr + 2560); ev0[jj] = *(const v4u*)(pr + 3072);
            ec1[jj] = *(const v4u*)(p1 + 2560); ev1[jj] = *(const v4u*)(p1 + 3072); ec2[jj] = *(const v4u*)(p2 + 2560); ev2[jj] = *(const v4u*)(p2 + 3072);
        }
        {
            const int ti = w & 3; f32x4 sa[2] = {(f32x4){0.f, 0.f, 0.f, 0.f}, (f32x4){0.f, 0.f, 0.f, 0.f}};
#pragma unroll
            for (int kk = 0; kk < 4; ++kk) {
                const bf16x8 a = rowfrag(L + QT_OFF, lane, ti, kk);
#pragma unroll
                for (int x = 0; x < 2; ++x) { const bf16x8 bb = rowfrag(L + KT_OFF, lane, 2 * (w >> 2) + x, kk); sa[x] = __builtin_amdgcn_mfma_f32_16x16x32_bf16(a, bb, sa[x], 0, 0, 0); }
            }
#pragma unroll
            for (int x = 0; x < 2; ++x) { const int s = 16 * (2 * (w >> 2) + x) + fr;
#pragma unroll
                for (int j = 0; j < 4; ++j) { const int t = 16 * ti + 4 * fq + j; const float pv = (t >= s) ? sa[x][j] : 0.f; *(LAS bf16*)(L + PP_OFF + off8(t, s >> 3) + 2 * (s & 7)) = (bf16)f2bf(pv); } }
        }
        WG_BARRIER();
        {
            const int ti = w & 3; f32x4 oa[4];
#pragma unroll
            for (int n = 0; n < 4; ++n) oa[n] = (f32x4){0.f, 0.f, 0.f, 0.f};
#pragma unroll
            for (int kk = 0; kk < 2; ++kk) {
                const bf16x8 a = *(const LAS bf16x8*)(L + PP_OFF + off8(16 * ti + fr, 4 * kk + fq));
#pragma unroll
                for (int n = 0; n < 4; ++n) { const bf16x8 bb = trfrag(L + VT_OFF, lane, 4 * (w >> 2) + n, kk); oa[n] = __builtin_amdgcn_mfma_f32_16x16x32_bf16(a, bb, oa[n], 0, 0, 0); }
            }
#pragma unroll
            for (int kk = 0; kk < 4; ++kk) {
                const bf16x8 a = rowfrag(L + QH_OFF, lane, ti, kk);
#pragma unroll
                for (int n = 0; n < 4; ++n) { const bf16x8 bb = rowfrag(L + BF_OFF, lane, 4 * (w >> 2) + n, kk); oa[n] = __builtin_amdgcn_mfma_f32_16x16x32_bf16(a, bb, oa[n], 0, 0, 0); }
            }
            LAS float* OI = (LAS float*)(L + OI_OFF);
#pragma unroll
            for (int n = 0; n < 4; ++n) { const int v = 16 * (4 * (w >> 2) + n) + fr;
#pragma unroll
                for (int j = 0; j < 4; ++j) { const int t = 16 * ti + 4 * fq + j; OI[t * 128 + (v ^ (((t >> 2) & 1) << 4))] = oa[n][j]; } }
        }
        WG_BARRIER();
        {
            const LAS float* OI = (const LAS float*)(L + OI_OFF);
            float hgn[8], cgn[8], w0[8], w1[8], w2[8];
            { const int c8 = h * 128 + 8 * cc;
              const f32x4 a = *(const f32x4*)(hg_ + c8), b2 = *(const f32x4*)(hg_ + c8 + 4), c4 = *(const f32x4*)(cg + c8), d4 = *(const f32x4*)(cg + c8 + 4);
              const f32x4 k0a = *(const f32x4*)(cw + c8), k0b = *(const f32x4*)(cw + c8 + 4), k1a = *(const f32x4*)(cw + HW + c8), k1b = *(const f32x4*)(cw + HW + c8 + 4), k2a = *(const f32x4*)(cw + 2 * HW + c8), k2b = *(const f32x4*)(cw + 2 * HW + c8 + 4);
#pragma unroll
              for (int e = 0; e < 4; ++e) { hgn[e] = a[e]; hgn[4 + e] = b2[e]; cgn[e] = c4[e]; cgn[4 + e] = d4[e]; w0[e] = k0a[e]; w0[4 + e] = k0b[e]; w1[e] = k1a[e]; w1[4 + e] = k1b[e]; w2[e] = k2a[e]; w2[4 + e] = k2b[e]; } }
#pragma unroll
            for (int jj = 0; jj < 2; ++jj) {
                const int s = (tid >> 4) + 32 * jj; const size_t row = row0 + s;
                const int vo = (8 * cc) ^ (((s >> 2) & 1) << 4);
                const f32x4 oa4 = *(const LAS f32x4*)(OI + s * 128 + vo), ob4 = *(const LAS f32x4*)(OI + s * 128 + vo + 4);
                float o[8] = {oa4[0], oa4[1], oa4[2], oa4[3], ob4[0], ob4[1], ob4[2], ob4[3]};
                float ss = 0.f;
#pragma unroll
                for (int e = 0; e < 8; ++e) ss += o[e] * o[e];
                ss += __shfl_xor(ss, 1); ss += __shfl_xor(ss, 2); ss += __shfl_xor(ss, 4); ss += __shfl_xor(ss, 8);
                const float rs = rsqf_(ss * (1.f / 128.f) + EPS);
                float g[8]; unpack8(eg[jj], g);
                float yh[8];
#pragma unroll
                for (int e = 0; e < 8; ++e) yh[e] = o[e] * rs * hgn[e] * siluf_(g[e]);
                *(v4u*)(Y + row * D + h * 128 + 8 * cc) = (v4u){pk2(yh[0], yh[1]), pk2(yh[2], yh[3]), pk2(yh[4], yh[5]), pk2(yh[6], yh[7])};
                float bg[8], c0f[8], v0f[8], c1f[8], v1f[8], c2f[8], v2f[8];
                unpack8(eb[jj], bg); unpack8(ec0[jj], c0f); unpack8(ev0[jj], v0f); unpack8(ec1[jj], c1f); unpack8(ev1[jj], v1f); unpack8(ec2[jj], c2f); unpack8(ev2[jj], v2f);
                float yc[8]; float s2 = 0.f;
#pragma unroll
                for (int e = 0; e < 8; ++e) { const float cv = w0[e] * (c2f[e] * v2f[e]) + w1[e] * (c1f[e] * v1f[e]) + w2[e] * (c0f[e] * v0f[e]); yc[e] = bg[e] * cv; s2 += yc[e] * yc[e]; }
                s2 += __shfl_xor(s2, 1); s2 += __shfl_xor(s2, 2); s2 += __shfl_xor(s2, 4); s2 += __shfl_xor(s2, 8);
                const float rc = rsqf_(s2 * (1.f / 128.f) + EPS);
#pragma unroll
                for (int e = 0; e < 8; ++e) yc[e] = yc[e] * rc * cgn[e];
                *(v4u*)(Y + row * D + HW + h * 128 + 8 * cc) = (v4u){pk2(yc[0], yc[1]), pk2(yc[2], yc[3]), pk2(yc[4], yc[5]), pk2(yc[6], yc[7])};
            }
        }
    }
    WG_BARRIER();
}
constexpr int SEG_CH = 8, NSEG = 16;
__device__ __forceinline__ void seg_step(int bh, int seg, int k, int& h, int& nvalid, size_t& row0, int& chunk) {
    h = bh & 3;
    if (seg == 0) { if (k == 0) { row0 = NTOK; nvalid = NMETA; chunk = -1; return; } chunk = k - 1; }
    else chunk = seg * SEG_CH + k;
    row0 = (size_t)(bh >> 2) * SEQ + 64 * chunk; nvalid = 64;
}
template <bool LOGD>
__device__ __forceinline__ void state_step(LAS unsigned char* L, int lane, int w, f32x4 (&S)[8], float (&logd)[4]) {
    const int fq = lane >> 4;
    const LAS float* BMID = (const LAS float*)(L + BMID_OFF); const LAS float* BLAST = (const LAS float*)(L + BLAST_OFF);
    float sc[4], dc[4];
#pragma unroll
    for (int j = 0; j < 4; ++j) { const int d = 16 * w + 4 * fq + j; const float bl = BLAST[d]; sc[j] = fexp_(bl - BMID[d]); dc[j] = fexp_(bl); if (LOGD) logd[j] += bl; }
    const bf16x8 a0 = trfrag(L + KT_OFF, lane, w, 0), a1 = trfrag(L + KT_OFF, lane, w, 1);
#pragma unroll
    for (int hf = 0; hf < 2; ++hf) {
        f32x4 acc[4];
#pragma unroll
        for (int n = 0; n < 4; ++n) { acc[n] = (f32x4){0.f, 0.f, 0.f, 0.f};
            acc[n] = __builtin_amdgcn_mfma_f32_16x16x32_bf16(a0, trfrag(L + VT_OFF, lane, 4 * hf + n, 0), acc[n], 0, 0, 0);
            acc[n] = __builtin_amdgcn_mfma_f32_16x16x32_bf16(a1, trfrag(L + VT_OFF, lane, 4 * hf + n, 1), acc[n], 0, 0, 0); }
#pragma unroll
        for (int n = 0; n < 4; ++n)
#pragma unroll
            for (int j = 0; j < 4; ++j) S[4 * hf + n][j] = S[4 * hf + n][j] * dc[j] + acc[n][j] * sc[j];
    }
}
__device__ __forceinline__ void pass_a2(Frame& F) {
    const bf16* PROJ = (const bf16*)(F.ws + WS_PROJ); const float* LB = (const float*)(F.ws + WS_LB);
    float* DSEG = (float*)(F.ws + WS_SS); float* DDSEG = (float*)(F.ws + WS_DD);
    LAS unsigned char* L = F.lds; const int lane = F.lane, fr = lane & 15, fq = lane >> 4, w = F.wave;
    for (int it = F.vcu; it < 16 * NSEG; it += F.G) {
        const int bh = it >> 4, seg = it & 15, nsteps = SEG_CH + (seg == 0 ? 1 : 0);
        f32x4 S[8]; float logd[4] = {0.f, 0.f, 0.f, 0.f};
#pragma unroll
        for (int n = 0; n < 8; ++n) S[n] = (f32x4){0.f, 0.f, 0.f, 0.f};
        Chunks ch; { int h, nv, c; size_t r0; seg_step(bh, seg, 0, h, nv, r0, c); load_chunks<false>(ch, PROJ, r0, h, nv, F.tid); }
        for (int k = 0; k < nsteps; ++k) {
            int h, nvalid, c; size_t row0; seg_step(bh, seg, k, h, nvalid, row0, c);
            prep<false>(F, ch, LB, h, nvalid);
            if (k + 1 < nsteps) { int h2, nv2, c2; size_t r2; seg_step(bh, seg, k + 1, h2, nv2, r2, c2); load_chunks<false>(ch, PROJ, r2, h2, nv2, F.tid); }
            state_step<true>(L, lane, w, S, logd);
            if (seg == 0 && k == 0 && bh < 4) {
                float* sm = (float*)(F.ws + WS_DSM) + (size_t)bh * 16384;
#pragma unroll
                for (int n = 0; n < 8; ++n) *(f32x4*)(sm + (size_t)(16 * n + fr) * 128 + 16 * w + 4 * fq) = S[n];
            }
            WG_BARRIER();
        }
        float* dst = DSEG + (size_t)it * 16384;
#pragma unroll
        for (int n = 0; n < 8; ++n) *(f32x4*)(dst + (size_t)(16 * n + fr) * 128 + 16 * w + 4 * fq) = S[n];
        if (fr == 0) *(f32x4*)(DDSEG + (size_t)it * 128 + 16 * w + 4 * fq) = (f32x4){fexp_(logd[0]), fexp_(logd[1]), fexp_(logd[2]), fexp_(logd[3])};
    }
}
__device__ __forceinline__ void pass_c2(Frame& F) {
    const bf16* PROJ = (const bf16*)(F.ws + WS_PROJ); const float* LB = (const float*)(F.ws + WS_LB); bf16* Y = (bf16*)(F.ws + WS_Y);
    const float* DSEG = (const float*)(F.ws + WS_SS); const float* DDSEG = (const float*)(F.ws + WS_DD);
    const float* hg_ = F.in[5]; const float* cw = F.in[6]; const float* cg = F.in[7];
    LAS unsigned char* L = F.lds; const int w = F.wave;
    for (int it = F.vcu; it < 16 * NSEG; it += F.G) {
        const int bh = it >> 4, seg = it & 15, b = bh >> 2, h = bh & 3, nsteps = SEG_CH;
        int tid0 = F.tid; asm volatile("" : "+v"(tid0)); int lane0 = tid0 & 63;
        if (tid0 < 128) { LAS float* CT = (LAS float*)(L + CONST_OFF); const int c8 = h * 128 + tid0; CT[tid0] = hg_[c8]; CT[128 + tid0] = cg[c8]; CT[256 + tid0] = cw[c8]; CT[384 + tid0] = cw[HW + c8]; CT[512 + tid0] = cw[2 * HW + c8]; }
        Chunks ch; { int h0, nv, c; size_t r0; seg_step(bh, seg, seg == 0 ? 1 : 0, h0, nv, r0, c); load_chunks<true, false, true>(ch, PROJ, r0, h0, nv, tid0); }
        f32x4 S[8]; float logd[4] = {0.f, 0.f, 0.f, 0.f};
#pragma unroll
        for (int n = 0; n < 8; ++n) S[n] = (f32x4){0.f, 0.f, 0.f, 0.f};
        { const int fr = lane0 & 15, fq = lane0 >> 4;
        if (seg == 0) { const float* sm = (const float*)(F.ws + WS_DSM) + (size_t)h * 16384;
#pragma unroll
            for (int n = 0; n < 8; ++n) S[n] = *(const f32x4*)(sm + (size_t)(16 * n + fr) * 128 + 16 * w + 4 * fq); }
        for (int g = 0; g < seg; ++g) {
            const float* src = DSEG + (size_t)(bh * NSEG + g) * 16384; const f32x4 dg = *(const f32x4*)(DDSEG + (size_t)(bh * NSEG + g) * 128 + 16 * w + 4 * fq);
#pragma unroll
            for (int n = 0; n < 8; ++n) { const f32x4 ds = *(const f32x4*)(src + (size_t)(16 * n + fr) * 128 + 16 * w + 4 * fq); S[n] = S[n] * dg + ds; }
        } }
        for (int k = 0; k < nsteps; ++k) {
            int hh, nvalid, c; size_t row0; seg_step(bh, seg, k + (seg == 0 ? 1 : 0), hh, nvalid, row0, c);
            int tl = tid0; asm volatile("" : "+v"(tl)); const int tid = tl, cc = tl & 15, ln = tl & 63, fr = ln & 15, fq = ln >> 4;
            if (c < 0) {
                prep<false>(F, ch, LB, h, nvalid, tid);
                { int h2, nv2, c2; size_t r2; seg_step(bh, seg, k + 1, h2, nv2, r2, c2); load_chunks<true, false, true>(ch, PROJ, r2, h2, nv2, tid); }
                state_step<false>(L, ln, w, S, logd);
                WG_BARRIER();
                continue;
            }
            { const char* base = (const char*)PROJ;
#pragma unroll
              for (int jj = 0; jj < 2; ++jj) { const int s = (tid >> 4) + 32 * jj; ch.v[jj] = __builtin_nontemporal_load((const v4u*)(base + (unsigned)(((unsigned)row0 + (unsigned)s) * (unsigned)PW + (unsigned)(h * 128 + 8 * cc)) * 2u + 2048)); } }
            prep<true>(F, ch, LB, h, 64, tid);
#pragma unroll
            for (int n = 0; n < 8; ++n) { const int v = 16 * n + fr, d = 16 * w + 4 * fq; *(LAS v2u*)(L + BF_OFF + offb(v, d >> 3) + 2 * (d & 7)) = (v2u){pk2(S[n][0], S[n][1]), pk2(S[n][2], S[n][3])}; }
            v4u eg[2], eb[2], ec0[2], ev0[2], ec1[2], ev1[2], ec2[2], ev2[2];
#define HG_EPI_LOAD(jj) do { const int s = (tid >> 4) + 32 * (jj), t = 64 * c + s; const char* pb = (const char*)PROJ; const unsigned col = (unsigned)(h * 128 + 8 * cc) * 2u; \
                const unsigned o0 = ((unsigned)row0 + (unsigned)s) * (unsigned)(PW * 2) + col; \
                const unsigned o1 = (t >= 1) ? o0 - (unsigned)(PW * 2) : (unsigned)(NTOK + 15) * (unsigned)(PW * 2) + col; \
                const unsigned o2 = (t >= 2) ? o0 - (unsigned)(PW * 4) : (unsigned)(NTOK + 14 + t) * (unsigned)(PW * 2) + col; \
                eg[jj] = __builtin_nontemporal_load((const v4u*)(pb + o0 + 3072)); eb[jj] = __builtin_nontemporal_load((const v4u*)(pb + o0 + 4096)); ec0[jj] = *(const v4u*)(pb + o0 + 5120); ev0[jj] = *(const v4u*)(pb + o0 + 6144); \
                ec1[jj] = *(const v4u*)(pb + o1 + 5120); ev1[jj] = *(const v4u*)(pb + o1 + 6144); ec2[jj] = *(const v4u*)(pb + o2 + 5120); ev2[jj] = *(const v4u*)(pb + o2 + 6144); } while (0)
            HG_EPI_LOAD(0);
            {
                const int ti = w & 3; f32x4 sa[2] = {(f32x4){0.f, 0.f, 0.f, 0.f}, (f32x4){0.f, 0.f, 0.f, 0.f}};
#pragma unroll
                for (int kk = 0; kk < 4; ++kk) {
                    const bf16x8 a = rowfrag(L + QT_OFF, ln, ti, kk);
#pragma unroll
                    for (int x = 0; x < 2; ++x) { const bf16x8 bb = rowfrag(L + KT_OFF, ln, 2 * (w >> 2) + x, kk); sa[x] = __builtin_amdgcn_mfma_f32_16x16x32_bf16(a, bb, sa[x], 0, 0, 0); }
                }
#pragma unroll
                for (int x = 0; x < 2; ++x) { const int s = 16 * (2 * (w >> 2) + x) + fr;
#pragma unroll
                    for (int j = 0; j < 4; ++j) { const int t = 16 * ti + 4 * fq + j; const float pv = (t >= s) ? sa[x][j] : 0.f; *(LAS bf16*)(L + PP_OFF + off8(t, s >> 3) + 2 * (s & 7)) = (bf16)f2bf(pv); } }
            }
            WG_BARRIER();
            state_step<false>(L, ln, w, S, logd);
            if (k + 1 < nsteps) { int h2, nv2, c2; size_t r2; seg_step(bh, seg, k + 1 + (seg == 0 ? 1 : 0), h2, nv2, r2, c2); load_chunks<true, false, true>(ch, PROJ, r2, h2, nv2, tid); }
            HG_EPI_LOAD(1);
            {
                const int ti = w & 3; f32x4 oa[4];
#pragma unroll
                for (int n = 0; n < 4; ++n) oa[n] = (f32x4){0.f, 0.f, 0.f, 0.f};
#pragma unroll
                for (int kk = 0; kk < 2; ++kk) {
                    const bf16x8 a = *(const LAS bf16x8*)(L + PP_OFF + off8(16 * ti + fr, 4 * kk + fq));
#pragma unroll
                    for (int n = 0; n < 4; ++n) { const bf16x8 bb = trfrag(L + VT_OFF, ln, 4 * (w >> 2) + n, kk); oa[n] = __builtin_amdgcn_mfma_f32_16x16x32_bf16(a, bb, oa[n], 0, 0, 0); }
                }
#pragma unroll
                for (int kk = 0; kk < 4; ++kk) {
                    const bf16x8 a = rowfrag(L + QH_OFF, ln, ti, kk);
#pragma unroll
                    for (int n = 0; n < 4; ++n) { const bf16x8 bb = rowfrag(L + BF_OFF, ln, 4 * (w >> 2) + n, kk); oa[n] = __builtin_amdgcn_mfma_f32_16x16x32_bf16(a, bb, oa[n], 0, 0, 0); }
                }
#pragma unroll
                for (int n = 0; n < 4; ++n) { const int v = 16 * (4 * (w >> 2) + n) + fr;
#pragma unroll
                    for (int j = 0; j < 4; ++j) { const int t = 16 * ti + 4 * fq + j; *(LAS bf16*)(L + QT_OFF + offb(t, v >> 3) + 2 * (v & 7)) = (bf16)f2bf(oa[n][j]); } }
            }
#undef HG_EPI_LOAD
            WG_BARRIER();
            {
                const LAS float* CT = (const LAS float*)(L + CONST_OFF);
#pragma unroll
                for (int jj = 0; jj < 2; ++jj) {
                    const int s = (tid >> 4) + 32 * jj; const unsigned yo = (((unsigned)row0 + (unsigned)s) * (unsigned)D + (unsigned)(h * 128 + 8 * cc)) * 2u;
                    const v4u ow = *(const LAS v4u*)(L + QT_OFF + offb(s, cc)); float o[8]; unpack8(ow, o);
                    float ss = 0.f;
#pragma unroll
                    for (int e = 0; e < 8; ++e) ss += o[e] * o[e];
                    ss += __shfl_xor(ss, 1); ss += __shfl_xor(ss, 2); ss += __shfl_xor(ss, 4); ss += __shfl_xor(ss, 8);
                    const float rs = rsqf_(ss * (1.f / 128.f) + EPS);
                    float g[8]; unpack8(eg[jj], g);
                    const f32x4 ha = *(const LAS f32x4*)(CT + 8 * cc), hb = *(const LAS f32x4*)(CT + 8 * cc + 4);
                    float yh[8];
#pragma unroll
                    for (int e = 0; e < 8; ++e) yh[e] = o[e] * rs * (e < 4 ? ha[e] : hb[e - 4]) * siluf_(g[e]);
                    *(v4u*)((char*)Y + yo) = (v4u){pk2(yh[0], yh[1]), pk2(yh[2], yh[3]), pk2(yh[4], yh[5]), pk2(yh[6], yh[7])};
                }
#pragma unroll
                for (int jj = 0; jj < 2; ++jj) {
                    const int s = (tid >> 4) + 32 * jj; const unsigned yo = (((unsigned)row0 + (unsigned)s) * (unsigned)D + (unsigned)(h * 128 + 8 * cc)) * 2u;
                    float cf[8], vf[8], cv[8];
                    unpack8(ec2[jj], cf); unpack8(ev2[jj], vf);
                    { const f32x4 wa = *(const LAS f32x4*)(CT + 256 + 8 * cc), wb = *(const LAS f32x4*)(CT + 256 + 8 * cc + 4);
#pragma unroll
                      for (int e = 0; e < 8; ++e) cv[e] = (e < 4 ? wa[e] : wb[e - 4]) * (cf[e] * vf[e]); }
                    unpack8(ec1[jj], cf); unpack8(ev1[jj], vf);
                    { const f32x4 wa = *(const LAS f32x4*)(CT + 384 + 8 * cc), wb = *(const LAS f32x4*)(CT + 384 + 8 * cc + 4);
#pragma unroll
                      for (int e = 0; e < 8; ++e) cv[e] += (e < 4 ? wa[e] : wb[e - 4]) * (cf[e] * vf[e]); }
                    unpack8(ec0[jj], cf); unpack8(ev0[jj], vf);
                    { const f32x4 wa = *(const LAS f32x4*)(CT + 512 + 8 * cc), wb = *(const LAS f32x4*)(CT + 512 + 8 * cc + 4);
#pragma unroll
                      for (int e = 0; e < 8; ++e) cv[e] += (e < 4 ? wa[e] : wb[e - 4]) * (cf[e] * vf[e]); }
                    unpack8(eb[jj], cf);
                    float s2 = 0.f;
#pragma unroll
                    for (int e = 0; e < 8; ++e) { cv[e] *= cf[e]; s2 += cv[e] * cv[e]; }
                    s2 += __shfl_xor(s2, 1); s2 += __shfl_xor(s2, 2); s2 += __shfl_xor(s2, 4); s2 += __shfl_xor(s2, 8);
                    const float rc = rsqf_(s2 * (1.f / 128.f) + EPS);
                    const f32x4 ga = *(const LAS f32x4*)(CT + 128 + 8 * cc), gb = *(const LAS f32x4*)(CT + 128 + 8 * cc + 4);
#pragma unroll
                    for (int e = 0; e < 8; ++e) cv[e] = cv[e] * rc * (e < 4 ? ga[e] : gb[e - 4]);
                    *(v4u*)((char*)Y + yo + 1024) = (v4u){pk2(cv[0], cv[1]), pk2(cv[2], cv[3]), pk2(cv[4], cv[5]), pk2(cv[6], cv[7])};
                }
            }
        }
        WG_BARRIER();
    }
}
}

__device__ __forceinline__ void post_phase(Frame& F) {
    const bf16* PROJ = (const bf16*)(F.ws + WS_PROJ); const float* ORAW = (const float*)(F.ws + WS_ORAW); bf16* Y = (bf16*)(F.ws + WS_Y);
    const float* hg = F.in[5]; const float* cw = F.in[6]; const float* cg = F.in[7];
    const int gw = F.vcu * NWAVES + F.wave, NGW = F.G * NWAVES, lane = F.lane, c0 = 8 * lane;
    for (int row = gw; row < NTOK; row += NGW) {
        const int t = row & (SEQ - 1);
        const bf16* pr = PROJ + (size_t)row * PW;
        float o[8]; { const f32x4 a = *(const f32x4*)(ORAW + (size_t)row * HW + c0), b2 = *(const f32x4*)(ORAW + (size_t)row * HW + c0 + 4);
            o[0] = a.x; o[1] = a.y; o[2] = a.z; o[3] = a.w; o[4] = b2.x; o[5] = b2.y; o[6] = b2.z; o[7] = b2.w; }
        float ss = 0.f;
#pragma unroll
        for (int j = 0; j < 8; ++j) ss += o[j] * o[j];
        ss += __shfl_xor(ss, 1); ss += __shfl_xor(ss, 2); ss += __shfl_xor(ss, 4); ss += __shfl_xor(ss, 8);
        const float rs = rsqf_(ss * (1.f / 128.f) + EPS);
        const v4u gq = *(const v4u*)(pr + 1536 + c0);
        float gv[8] = {bflo(gq.x), bfhi(gq.x), bflo(gq.y), bfhi(gq.y), bflo(gq.z), bfhi(gq.z), bflo(gq.w), bfhi(gq.w)};
        float yh[8];
#pragma unroll
        for (int j = 0; j < 8; ++j) yh[j] = o[j] * rs * hg[c0 + j] * siluf_(gv[j]);
        v4u oh; oh.x = pk2(yh[0], yh[1]); oh.y = pk2(yh[2], yh[3]); oh.z = pk2(yh[4], yh[5]); oh.w = pk2(yh[6], yh[7]);
        *(v4u*)(Y + (size_t)row * D + c0) = oh;
        const bf16* p1 = (t >= 1) ? pr - PW : PROJ + (size_t)(NTOK + 15) * PW;
        const bf16* p2 = (t >= 2) ? pr - 2 * PW : PROJ + (size_t)(NTOK + 14 + t) * PW;
        float u0[8], u1[8], u2[8], bg[8];
        { const v4u c = *(const v4u*)(pr + 2560 + c0), v = *(const v4u*)(pr + 3072 + c0), bq = *(const v4u*)(pr + 2048 + c0);
          const unsigned cc[4] = {c.x, c.y, c.z, c.w}, vv[4] = {v.x, v.y, v.z, v.w}, bb[4] = {bq.x, bq.y, bq.z, bq.w};
#pragma unroll
          for (int j = 0; j < 4; ++j) { u0[2 * j] = bflo(cc[j]) * bflo(vv[j]); u0[2 * j + 1] = bfhi(cc[j]) * bfhi(vv[j]); bg[2 * j] = bflo(bb[j]); bg[2 * j + 1] = bfhi(bb[j]); } }
        { const v4u c = *(const v4u*)(p1 + 2560 + c0), v = *(const v4u*)(p1 + 3072 + c0); const unsigned cc[4] = {c.x, c.y, c.z, c.w}, vv[4] = {v.x, v.y, v.z, v.w};
#pragma unroll
          for (int j = 0; j < 4; ++j) { u1[2 * j] = bflo(cc[j]) * bflo(vv[j]); u1[2 * j + 1] = bfhi(cc[j]) * bfhi(vv[j]); } }
        { const v4u c = *(const v4u*)(p2 + 2560 + c0), v = *(const v4u*)(p2 + 3072 + c0); const unsigned cc[4] = {c.x, c.y, c.z, c.w}, vv[4] = {v.x, v.y, v.z, v.w};
#pragma unroll
          for (int j = 0; j < 4; ++j) { u2[2 * j] = bflo(cc[j]) * bflo(vv[j]); u2[2 * j + 1] = bfhi(cc[j]) * bfhi(vv[j]); } }
        float yc[8]; float s2 = 0.f;
#pragma unroll
        for (int j = 0; j < 8; ++j) { const float cv = cw[c0 + j] * u2[j] + cw[HW + c0 + j] * u1[j] + cw[2 * HW + c0 + j] * u0[j]; yc[j] = bg[j] * cv; s2 += yc[j] * yc[j]; }
        s2 += __shfl_xor(s2, 1); s2 += __shfl_xor(s2, 2); s2 += __shfl_xor(s2, 4); s2 += __shfl_xor(s2, 8);
        const float rc = rsqf_(s2 * (1.f / 128.f) + EPS);
#pragma unroll
        for (int j = 0; j < 8; ++j) yc[j] = yc[j] * rc * cg[c0 + j];
        v4u oc; oc.x = pk2(yc[0], yc[1]); oc.y = pk2(yc[2], yc[3]); oc.z = pk2(yc[4], yc[5]); oc.w = pk2(yc[6], yc[7]);
        *(v4u*)(Y + (size_t)row * D + HW + c0) = oc;
    }
}

__device__ __forceinline__ void router_phase(Frame& F) {
    const bf16* H1 = (const bf16*)(F.ws + WS_H1); const bf16* WrT = (const bf16*)(F.ws + WS_WR); const float* sumsq = (const float*)(F.ws + WS_SUMSQ);
    int* tokl = (int*)(F.ws + WS_TOK); f32x2* scl = (f32x2*)(F.ws + WS_SCL); f32x2* scls = (f32x2*)(F.ws + WS_SCLS); int* slot = (int*)(F.ws + WS_SLOT);
    unsigned* counts = (unsigned*)(F.ws + WS_CTL) + CW_CNT; const float* rbias = F.in[11];
    const int lane = F.lane, fr = lane & 15, fq = lane >> 4, w = F.wave, tid = F.tid;
    LAS float* sc = (LAS float*)F.lds + w * 2048;
    LAS float* kb = sc + 1024;
    LAS int* hist = (LAS int*)(F.lds + 65536);
    LAS int* base = hist + 64;
    LAS int* sel_e = base + 64;
    LAS int* sel_r = sel_e + 1024;
    LAS float* sel_g = (LAS float*)(sel_r + 1024);
    LAS float* sel_rs = sel_g + 1024;
    float bias4[4];
#pragma unroll
    for (int n = 0; n < 4; ++n) bias4[n] = rbias[16 * n + fr];
    for (int blk = F.vcu; blk < NTOK / 128; blk += F.G) {
        if (tid < 64) hist[tid] = 0;
        __syncthreads();
        const int tok0 = blk * 128 + w * 16;
        f32x4 acc[4];
#pragma unroll
        for (int n = 0; n < 4; ++n) acc[n] = (f32x4){0.f, 0.f, 0.f, 0.f};
        const char* ap = (const char*)(H1 + (size_t)(tok0 + fr) * D + 8 * fq);
#define RT_STAGE(q) do { _Pragma("unroll") for (int i = 0; i < 4; ++i) { const int pp = (w * 4 + i) * 64 + lane, row = pp >> 5, lc = (pp & 31) ^ (row & 15); \
            __builtin_amdgcn_global_load_lds((const unsigned*)((const char*)WrT + (size_t)row * (D * 2) + (q) * 512 + lc * 16), (LAS unsigned*)(F.lds + ((q) & 1) * 32768 + (w * 4 + i) * 1024), 16, 0, 0); } } while (0)
        bf16x8 a0[8], a1[8];
        RT_STAGE(0);
#pragma unroll
        for (int ks = 0; ks < 8; ++ks) a0[ks] = *(const bf16x8*)(ap + ks * 64);
#pragma unroll
        for (int q = 0; q < 4; ++q) {
            asm volatile("s_waitcnt vmcnt(0)" ::: "memory");
            WG_BARRIER();
            if (q + 1 < 4) { RT_STAGE(q + 1);
#pragma unroll
                for (int ks = 0; ks < 8; ++ks) { if (q & 1) a0[ks] = *(const bf16x8*)(ap + (q + 1) * 512 + ks * 64); else a1[ks] = *(const bf16x8*)(ap + (q + 1) * 512 + ks * 64); } }
            const LAS unsigned char* Bq = F.lds + (q & 1) * 32768;
#pragma unroll
            for (int ks = 0; ks < 8; ++ks)
#pragma unroll
                for (int n = 0; n < 4; ++n) { const int row = 16 * n + fr; const bf16x8 b = *(const LAS bf16x8*)(Bq + row * 512 + (((4 * ks + fq) ^ (row & 15)) << 4));
                    acc[n] = __builtin_amdgcn_mfma_f32_16x16x32_bf16((q & 1) ? a1[ks] : a0[ks], b, acc[n], 0, 0, 0); }
        }
#undef RT_STAGE
        WG_BARRIER();
#pragma unroll
        for (int j = 0; j < 4; ++j) { const int r = 4 * fq + j; const float rs = rsqf_(sumsq[tok0 + r] * (1.f / D) + EPS);
#pragma unroll
            for (int n = 0; n < 4; ++n) { const int e = 16 * n + fr; const float s = sigmoidf_(acc[n][j] * rs); sc[r * 64 + e] = s;
                kb[r * 64 + e] = __builtin_bit_cast(float, (__builtin_bit_cast(unsigned, s + bias4[n]) & ~63u) | (unsigned)(63 - e)); }
            if (fr == 0) { sel_rs[w * 16 + r] = rs; scls[tok0 + r] = (f32x2){rs, rs}; } }
        LDS_WAIT(); asm volatile("" ::: "memory");
#pragma unroll 2
        for (int r = 0; r < 16; ++r) {
            const float my = kb[r * 64 + lane]; int rank = 0;
#pragma unroll
            for (int e4 = 0; e4 < 16; ++e4) { const f32x4 o = *(const LAS f32x4*)(kb + r * 64 + 4 * e4); rank += (o[0] > my) + (o[1] > my) + (o[2] > my) + (o[3] > my); }
            if (rank < TOPK) { const int tl = w * 16 + r; sel_e[tl * 8 + rank] = lane; sel_g[tl * 8 + rank] = sc[r * 64 + lane];
                sel_r[tl * 8 + rank] = __hip_atomic_fetch_add(hist + lane, 1, __ATOMIC_RELAXED, __HIP_MEMORY_SCOPE_WORKGROUP); }
        }
        __syncthreads();
        if (tid < 64) base[tid] = (int)atomicAdd(counts + tid, (unsigned)hist[tid]);
        __syncthreads();
        for (int i = tid; i < 1024; i += NTHREADS) {
            const int e = sel_e[i], pos = base[e] + sel_r[i], token = blk * 128 + (i >> 3);
            const LAS f32x4* g4 = (const LAS f32x4*)(sel_g + (i & ~7)); const f32x4 ga = g4[0], gb = g4[1];
            const float ssum = ((ga[0] + ga[1]) + (ga[2] + ga[3])) + ((gb[0] + gb[1]) + (gb[2] + gb[3]));
            const float rs = sel_rs[i >> 3]; tokl[(size_t)e * NTOK + pos] = token; scl[(size_t)e * NTOK + pos] = (f32x2){rs, rs * sel_g[i] * (ROUTED_SCALE / ssum)}; slot[(size_t)token * 8 + (i & 7)] = (e << 16) | pos;
        }
        __syncthreads();
    }
}

struct CRows { v2u h[4]; unsigned ys[4]; unsigned y[8][4]; };
__device__ __forceinline__ void comb_issue(CRows& r, int tok, int sl, const bf16* H1, const unsigned char* YR, const unsigned char* YS, const MoeTab& T, int c0) {
    asm volatile("" : "+v"(c0));
    const unsigned ho = (unsigned)tok * (D * 2) + 2 * c0, so = (unsigned)tok * D + c0;
#pragma unroll
    for (int j = 0; j < 4; ++j) { r.h[j] = __builtin_nontemporal_load((const v2u*)((const char*)H1 + ho + 512 * j)); r.ys[j] = __builtin_nontemporal_load((const unsigned*)(YS + so + 256 * j)); }
#pragma unroll
    for (int k = 0; k < TOPK; ++k) { const int s = __shfl(sl, k); const int e = s >> 16, pos = s & 0xffff; const unsigned yo = (unsigned)(T.rowbase[e] + pos) * D + c0;
#pragma unroll
        for (int j = 0; j < 4; ++j) r.y[k][j] = __builtin_nontemporal_load((const unsigned*)(YR + yo + 256 * j)); }
}
__device__ __forceinline__ void comb_finish(const CRows& r, int tok, float* out, const float* gf, int c0) {
    float v[16];
#pragma unroll
    for (int j = 0; j < 4; ++j) { v[4 * j] = bflo(r.h[j].x); v[4 * j + 1] = bfhi(r.h[j].x); v[4 * j + 2] = bflo(r.h[j].y); v[4 * j + 3] = bfhi(r.h[j].y); }
#pragma unroll
    for (int k = 0; k <= TOPK; ++k) {
#pragma unroll
        for (int j = 0; j < 4; ++j) { const unsigned yy = (k < TOPK) ? r.y[k < TOPK ? k : 0][j] : r.ys[j];
            const f32x2 lo = __builtin_amdgcn_cvt_pk_f32_fp8((int)yy, false), hi = __builtin_amdgcn_cvt_pk_f32_fp8((int)yy, true);
            v[4 * j] += lo.x * (1.f / YSCALE); v[4 * j + 1] += lo.y * (1.f / YSCALE); v[4 * j + 2] += hi.x * (1.f / YSCALE); v[4 * j + 3] += hi.y * (1.f / YSCALE); }
        asm volatile("" : "+v"(v[0]), "+v"(v[1]), "+v"(v[2]), "+v"(v[3]), "+v"(v[4]), "+v"(v[5]), "+v"(v[6]), "+v"(v[7]), "+v"(v[8]), "+v"(v[9]), "+v"(v[10]), "+v"(v[11]), "+v"(v[12]), "+v"(v[13]), "+v"(v[14]), "+v"(v[15]));
    }
    float ss = 0.f;
#pragma unroll
    for (int j = 0; j < 16; ++j) ss += v[j] * v[j];
    const float rs = rsqf_(wave_sum(ss) * (1.f / D) + EPS);
    float* o = out + (size_t)tok * D + c0;
#pragma unroll
    for (int j = 0; j < 4; ++j) { const f32x4 g = *(const f32x4*)(gf + c0 + 256 * j);
        OUT_STORE(((f32x4){v[4 * j] * rs * g.x, v[4 * j + 1] * rs * g.y, v[4 * j + 2] * rs * g.z, v[4 * j + 3] * rs * g.w}), (f32x4*)(o + 256 * j)); }
}
__device__ __forceinline__ void combine_phase(Frame& F, const MoeTab& T) {
    const bf16* H1 = (const bf16*)(F.ws + WS_H1); const unsigned char* YR = F.ws + WS_YR; const unsigned char* YS = F.ws + WS_YS; const int* slot = (const int*)(F.ws + WS_SLOT); const float* gf = F.in[18];
    const int gw = F.vcu * NWAVES + F.wave, NGW = F.G * NWAVES, lane = F.lane, c0 = 4 * lane;
    if (gw >= NTOK) return;
    CRows ra, rb;
    int tok = gw;
    int sl = slot[(size_t)tok * 8 + (lane & 7)];
    comb_issue(ra, tok, sl, H1, YR, YS, T, c0);
    int sln = (tok + NGW < NTOK) ? slot[(size_t)(tok + NGW) * 8 + (lane & 7)] : 0;
    for (;;) {
        const int t1 = tok + NGW, t2 = tok + 2 * NGW, t3 = tok + 3 * NGW;
        if (t1 < NTOK) comb_issue(rb, t1, sln, H1, YR, YS, T, c0);
        int sl2 = (t2 < NTOK) ? slot[(size_t)t2 * 8 + (lane & 7)] : 0;
        __builtin_amdgcn_sched_barrier(0);
        comb_finish(ra, tok, F.out, gf, c0);
        __builtin_amdgcn_sched_barrier(0);
        if (t1 >= NTOK) break;
        if (t2 < NTOK) comb_issue(ra, t2, sl2, H1, YR, YS, T, c0);
        sln = (t3 < NTOK) ? slot[(size_t)t3 * 8 + (lane & 7)] : 0;
        __builtin_amdgcn_sched_barrier(0);
        comb_finish(rb, t1, F.out, gf, c0);
        __builtin_amdgcn_sched_barrier(0);
        if (t2 >= NTOK) break;
        tok = t2;
    }
}

__global__ void __launch_bounds__(NTHREADS, 2) mega_fwd(Args args) {
    extern __shared__ __attribute__((aligned(16))) unsigned char lds[];
    Frame F;
    F.lds = (LAS unsigned char*)lds;
    F.tid = threadIdx.x; F.lane = F.tid & 63; F.wave = __builtin_amdgcn_readfirstlane(F.tid >> 6);
    F.G = gridDim.x; { const int bx = blockIdx.x; F.vcu = (F.G % 8 == 0) ? (bx % 8) * (F.G / 8) + bx / 8 : bx; }
#pragma unroll
    for (int i = 0; i < 19; ++i) F.in[i] = args.in[i];
    F.out = args.out; F.ws = args.ws;
    volatile LAS unsigned* MISC = (volatile LAS unsigned*)(F.lds + MISC_OFF);
    for (int u = F.tid; u < 32; u += NTHREADS) MISC[u] = 0u;
    __syncthreads();
    unsigned* ctl = (unsigned*)(F.ws + WS_CTL);
    XcdBarrier bar = xcd_barrier_post(ctl + CW_BAR, MISC + 8);
    const int lo = args.ph_lo, hi = args.ph_hi;
#define IN(k) (lo <= (k) && (k) < hi)
#define BOTH(k) (IN(k) && IN((k) + 1))

    if (IN(0)) { REP(0) p0_prologue(F); if (BOTH(0)) xcd_barrier(bar); }
    if (IN(1)) {
        constexpr int GEMM_CUS = GEMM_CUS_CFG;
        if ((int)blockIdx.x < GEMM_CUS || F.G <= GEMM_CUS) {
            ProbIn p{(const bf16*)(F.ws + WS_XN), (const bf16*)(F.ws + WS_WIN), (bf16*)(F.ws + WS_PROJ)};
            const int ge = F.G > GEMM_CUS ? GEMM_CUS : F.G;
#if FAST_GEMM & 1
            REP(1) fg::gemm_phase(F, p, ge);
#else
            simple_gemm_phase(F, p, ge);
#endif
        }
        if (F.G <= GEMM_CUS) { meta_proj(F, F.vcu * NWAVES + F.wave, F.G * NWAVES); if (GEMM_CUS_CFG < 256) p0_convert(F, P0_NONEXPERT + P0_SPLIT, P0_NITEMS, F.vcu * NWAVES + F.wave, F.G * NWAVES); }
        else if ((int)blockIdx.x >= GEMM_CUS) { const int gw = ((int)blockIdx.x - GEMM_CUS) * NWAVES + F.wave, ngw = (F.G - GEMM_CUS) * NWAVES; meta_proj(F, gw, ngw); p0_convert(F, P0_NONEXPERT + P0_SPLIT, P0_NITEMS, gw, ngw); }
        if (BOTH(1)) xcd_barrier(bar); }
#if FAST_HGRN
    if (IN(2)) {
#if HGRN_SEG
        hg::pass_a2(F); xcd_barrier(bar); hg::pass_c2(F);
#else
        REP(2) hg::pass_a(F); xcd_barrier(bar); REP(3) hg::scan_phase(F); xcd_barrier(bar); REP(4) hg::pass_c(F);
#endif
        if (BOTH(2)) xcd_barrier(bar); }
#else
    if (IN(2)) { hgrn_naive(F); if (BOTH(2)) xcd_barrier(bar); }
#endif
#if !FAST_HGRN
    if (IN(3)) { REP(5) post_phase(F); if (BOTH(3)) xcd_barrier(bar); }
#endif
    if (IN(4)) { ProbOut p{(const bf16*)(F.ws + WS_Y), (const bf16*)(F.ws + WS_WOUT), F.in[0], (bf16*)(F.ws + WS_H1), (float*)(F.ws + WS_SUMSQ), ProbE1::FP8 ? F.ws + WS_H1Q : nullptr, (const bf16*)(F.ws + WS_XN), (const float*)(F.ws + WS_RINV)};
#if FAST_GEMM & 2
        fg::gemm_phase(F, p);
#else
        simple_gemm_out(F, p);
#endif
        if (BOTH(4)) xcd_barrier(bar); }
    if (IN(5)) { router_phase(F); if (BOTH(5)) xcd_barrier(bar); }
    MoeTab T; T.cnt = nullptr; T.rowbase = nullptr; T.tb = nullptr;
    if (IN(6) || IN(7) || IN(8)) moe_build_tab(F, T);
    if (IN(6)) { ProbE1 p{T, ProbE1::FP8 ? (const bf16*)(F.ws + WS_H1Q) : (const bf16*)(F.ws + WS_H1), (const bf16*)((unsigned char*)F.out + OUT_WGU), (const int*)(F.ws + WS_TOK), (const f32x2*)(F.ws + WS_SCL), (const f32x2*)(F.ws + WS_SCLS), (bf16*)(F.ws + WS_HID), (LAS int*)(F.lds + IDX_OFF)};
#if FAST_GEMM & 4
        moe_fill_units(F, p, (LAS int*)(F.lds + UT_OFF)); e1_fill_idx(F, p); REP(6) fg::gemm_phase(F, p);
#else
        simple_gemm_phase(F, p);
#endif
        if (BOTH(6)) xcd_barrier(bar); }
    if (IN(7)) { ProbE2 p{T, (const bf16*)(F.ws + WS_HID), (const bf16*)((unsigned char*)F.out + OUT_WD), F.ws + WS_YS, F.ws + WS_YR, 0, 0};
#if (FAST_GEMM & 8) && E2_CUSTOM
        static_assert(ProbE2Q, "the dedicated down-GEMM body is fp8 only");
        p.ntl = 128; fg::gemm_phase(F, p);
        e2::phase(F, T, (const unsigned char*)(F.ws + WS_HID), (const unsigned char*)F.out + OUT_WD, F.ws + WS_YR, F.ws + WS_DD);
#elif FAST_GEMM & 8
        moe_fill_units(F, p, (LAS int*)(F.lds + UT_OFF)); fg::gemm_phase(F, p);
        if ((REPEAT >> 7) & 1) { p.t0 = 128; fg::gemm_phase(F, p); }
#else
        simple_gemm_phase(F, p);
#endif
        if (BOTH(7)) xcd_barrier(bar); }
    if (IN(8)) { REP(8) combine_phase(F, T); for (int _r = 0; _r < ((REPEAT >> 9) & 1) * 8; ++_r) xcd_barrier(bar); }
#undef IN
#undef BOTH
}

extern "C" void kernel_launch(void* const* d_in, const int* in_sizes, int n_in, void* d_out, int out_size, void* d_ws, size_t ws_size, hipStream_t stream) {
    static int grid = 0;
    if (grid == 0) {
        if (n_in != 19 || in_sizes[0] != NTOK * D || out_size != NTOK * D || ws_size < WS_END) { fprintf(stderr, "kernel_launch: unexpected shapes / workspace (n_in %d, in0 %d, out %d, ws %zu)\n", n_in, n_in > 0 ? in_sizes[0] : -1, out_size, ws_size); grid = -1; return; }
        int dev = 0, cus = 0, per_cu = 0;
        if (hipGetDevice(&dev) != hipSuccess || hipDeviceGetAttribute(&cus, hipDeviceAttributeMultiprocessorCount, dev) != hipSuccess) { grid = -1; return; }
        if (hipFuncSetAttribute((const void*)mega_fwd, hipFuncAttributeMaxDynamicSharedMemorySize, LDS_BYTES) != hipSuccess) { fprintf(stderr, "kernel_launch: hipFuncSetAttribute failed\n"); grid = -1; return; }
        if (hipOccupancyMaxActiveBlocksPerMultiprocessor(&per_cu, (const void*)mega_fwd, NTHREADS, LDS_BYTES) != hipSuccess || per_cu < 1) { fprintf(stderr, "kernel_launch: occupancy query reports %d workgroups per CU\n", per_cu); grid = -1; return; }
        if (cus < 256) { fprintf(stderr, "kernel_launch: built for a 256-CU device (per-CU unit tables are sized for a 256-workgroup grid); found %d CUs\n", cus); grid = -1; return; }
        grid = 256;
    }
    if (grid < 0) return;
    (void)hipMemsetAsync((char*)d_ws + WS_CTL, 0, CTL_ZERO_BYTES, stream);
    Args a{};
    for (int i = 0; i < 19; ++i) a.in[i] = (const float*)d_in[i];
    a.out = (float*)d_out; a.ws = (unsigned char*)d_ws; a.ph_lo = 0; a.ph_hi = 9;
    void* kargs[] = {&a};
    const hipError_t e = hipLaunchCooperativeKernel((const void*)mega_fwd, dim3(grid), dim3(NTHREADS), kargs, LDS_BYTES, stream);
    if (e != hipSuccess) fprintf(stderr, "kernel_launch: cooperative launch failed: %s (grid %d)\n", hipGetErrorString(e), grid);
}
```

```cpp
#include <hip/hip_runtime.h>
#include <cstdio>
#include <cstdint>

#define GAS __attribute__((address_space(1)))
#define LAS __attribute__((address_space(3)))
typedef unsigned short bf16;
typedef unsigned v4u __attribute__((ext_vector_type(4)));
typedef unsigned v2u __attribute__((ext_vector_type(2)));
typedef float f32x4 __attribute__((ext_vector_type(4)));
typedef float f32x2 __attribute__((ext_vector_type(2)));
typedef short bf16x8 __attribute__((ext_vector_type(8)));

#ifndef FAST_GEMM
#define FAST_GEMM 15
#endif
#ifndef REPEAT
#define REPEAT 0
#endif
#define REP(k) for (int _rep = 0; _rep < 1 + ((REPEAT >> (k)) & 1); ++_rep)
#ifndef P0_SPLIT
#define P0_SPLIT 12480
#endif
#ifndef GEMM_CUS_CFG
#define GEMM_CUS_CFG 224
#endif
#ifndef HGRN_SEG
#define HGRN_SEG 1
#endif
#ifndef FP8_E1
#define FP8_E1 1
#endif
#ifndef FP8_E2
#define FP8_E2 1
#endif
#ifndef FP8_OUT
#define FP8_OUT 1
#endif
#ifndef E2_CUSTOM
#define E2_CUSTOM 0
#endif
#ifndef FAST_HGRN
#define FAST_HGRN 1
#endif

constexpr int D = 1024, NB = 4, SEQ = 8192, NMETA = 16, NTOK = NB * SEQ, MROWS = 33024, PW = 3584, HW = 512;
constexpr int NE = 64, TOPK = 8, FF = 256;
constexpr float EPS = 1e-6f, ROUTED_SCALE = 2.5f, YSCALE = 16.f, WQ_SCALE = 32.f, HQ_SCALE = 8.f, WDQ_SCALE = 16.f, F8MAX = 448.f;
constexpr int NWAVES = 8, NTHREADS = NWAVES * 64;
constexpr int LDS_BYTES = 147456;
constexpr int RING_BYTES = 131072, MISC_OFF = RING_BYTES + 320, TAB_OFF = RING_BYTES + 1024, IDX_OFF = RING_BYTES + 2048, UT_OFF = RING_BYTES + 13312;

constexpr size_t MiB = 1u << 20;
constexpr size_t WS_CTL = 0, CTL_ZERO_BYTES = 1 * MiB;
constexpr int CW_BAR = 4096;
constexpr int CW_CNT = 32768;
constexpr size_t WS_SUMSQ = 256 * 1024;
constexpr size_t WS_TOK = 1 * MiB;
constexpr size_t WS_SCL = 9 * MiB;
constexpr size_t WS_SLOT = 25 * MiB;
constexpr size_t WS_SCLS = 26 * MiB;
constexpr size_t WS_RINV = 26 * MiB + 256 * 1024;
constexpr size_t WS_LB = 26 * MiB + 512 * 1024;
constexpr size_t WS_WIN = 27 * MiB;
constexpr size_t WS_WOUT = 34 * MiB;
constexpr size_t WS_WR = 36 * MiB;
constexpr size_t WS_XN = 37 * MiB;
constexpr size_t WS_Y = 429 * MiB;
constexpr size_t WS_PROJ = 102 * MiB;
constexpr size_t WS_ORAW = 328 * MiB;
constexpr size_t WS_DS = 37 * MiB;
constexpr size_t WS_SS = 392 * MiB;
constexpr size_t WS_DD = 494 * MiB;
constexpr size_t WS_DSM = 495 * MiB;
constexpr size_t WS_H1Q = 102 * MiB;
constexpr size_t WS_H1 = 293 * MiB;
constexpr size_t WS_HID = 357 * MiB;
constexpr size_t WS_YR = 37 * MiB;
constexpr size_t WS_YS = 430 * MiB;
constexpr size_t WS_END = 502 * MiB;
constexpr size_t OUT_WGU = 0, OUT_WD = (size_t)65 * 512 * 1024 * 2;

__device__ __forceinline__ float bf2f(bf16 h) { return __builtin_bit_cast(float, (unsigned)h << 16); }
__device__ __forceinline__ float bflo(unsigned w) { return __builtin_bit_cast(float, w << 16); }
__device__ __forceinline__ float bfhi(unsigned w) { return __builtin_bit_cast(float, w & 0xffff0000u); }
typedef __bf16 bf16x2_t __attribute__((ext_vector_type(2)));
__device__ __forceinline__ unsigned pk2(float lo, float hi) { const f32x2 v = {lo, hi}; return __builtin_bit_cast(unsigned, __builtin_convertvector(v, bf16x2_t)); }
__device__ __forceinline__ unsigned f2bf(float f) { return pk2(f, 0.f) & 0xffffu; }
__device__ __forceinline__ float fexp_(float x) { return __builtin_amdgcn_exp2f(x * 1.4426950408889634f); }
__device__ __forceinline__ float flog_(float x) { return __builtin_amdgcn_logf(x) * 0.6931471805599453f; }
__device__ __forceinline__ float rcpf_(float x) { return __builtin_amdgcn_rcpf(x); }
__device__ __forceinline__ float rsqf_(float x) { return __builtin_amdgcn_rsqf(x); }
__device__ __forceinline__ float sigmoidf_(float x) { return rcpf_(1.f + fexp_(-x)); }
__device__ __forceinline__ float siluf_(float x) { return x * rcpf_(1.f + fexp_(-x)); }
#define LDS_WAIT() asm volatile("s_waitcnt lgkmcnt(0)" ::: "memory")
#define WG_BARRIER() do { asm volatile("s_waitcnt lgkmcnt(0)" ::: "memory"); __builtin_amdgcn_s_barrier(); asm volatile("" ::: "memory"); } while (0)
#define VM_WAIT() asm volatile("s_waitcnt vmcnt(0)" ::: "memory")

#define XB_TMO      128
#define XB_XCNT(j)  (256  + 64 * (j))
#define XB_XSUB(j)  (1280 + 64 * (j))
#define XB_XGEN(j)  (2304 + 64 * (j))
#define XB_TOP      3328
#define XB_TOPGEN   3392
#define XCD_BAR_WORDS 3456
#define XB_SPIN_CAP (1u << 18)
__device__ __forceinline__ unsigned xb_ld(unsigned* p)              { return __hip_atomic_load(p, __ATOMIC_RELAXED, __HIP_MEMORY_SCOPE_AGENT); }
__device__ __forceinline__ unsigned xb_add(unsigned* p, unsigned v) { return __hip_atomic_fetch_add(p, v, __ATOMIC_RELAXED, __HIP_MEMORY_SCOPE_AGENT); }
__device__ __forceinline__ unsigned xb_xcc_id() { return (unsigned)__builtin_amdgcn_s_getreg((3 << 11) | 20) & 0xFu; }
#define XB_SPIN(cond, bar) do { unsigned _sp = 0; while (cond) { __builtin_amdgcn_s_sleep(1); \
    if ((++_sp & 255u) == 0u) { if (xb_ld(&(bar)[XB_TMO])) break; if (_sp > XB_SPIN_CAP) { atomicAdd(&(bar)[XB_TMO], 1u); break; } } } } while (0)
struct XcdBarrier { unsigned* bar; unsigned x; volatile LAS unsigned* st; };
__device__ __forceinline__ XcdBarrier xcd_barrier_post(unsigned* bar, volatile LAS unsigned* st) {
    XcdBarrier b; b.bar = bar; b.x = xb_xcc_id(); b.st = st;
    if (threadIdx.x == 0) (void)xb_add(&bar[XB_XCNT(b.x)], 1u);
    return b;
}
__device__ __forceinline__ void xcd_barrier_complete(unsigned* bar, unsigned x, unsigned& nloc, unsigned& nx) {
    const unsigned G = gridDim.x * gridDim.y * gridDim.z;
    unsigned sum, cnt, mine, sp = 0u;
    for (;;) {
        sum = 0u; cnt = 0u; mine = 0u;
#pragma unroll
        for (unsigned j = 0; j < 16; ++j) { const unsigned c = xb_ld(&bar[XB_XCNT(j)]); sum += c; cnt += (c > 0u) ? 1u : 0u; mine = (j == x) ? c : mine; }
        if (sum == G) break;
        __builtin_amdgcn_s_sleep(1);
        if ((++sp & 255u) == 0u) { if (xb_ld(&bar[XB_TMO])) break; if (sp > XB_SPIN_CAP) { atomicAdd(&bar[XB_TMO], 1u); break; } }
    }
    nloc = mine > 0u ? mine : 1u; nx = cnt > 0u ? cnt : 1u;
}
__device__ __forceinline__ void xcd_barrier(const XcdBarrier& b) {
    asm volatile("s_waitcnt vmcnt(0)" ::: "memory");
    __syncthreads();
    if (threadIdx.x == 0) {
        unsigned* bar = b.bar;
        __builtin_amdgcn_s_waitcnt(0);
        unsigned nloc = b.st[0], nx = b.st[1];
        if (nloc == 0u) { xcd_barrier_complete(bar, b.x, nloc, nx); b.st[0] = nloc; b.st[1] = nx; }
        const unsigned old = xb_add(&bar[XB_XSUB(b.x)], 1u);
        const unsigned gen = old / nloc;
        if (old + 1u == (gen + 1u) * nloc) {
            __builtin_amdgcn_fence(__ATOMIC_RELEASE, "agent");
            asm volatile("s_waitcnt vmcnt(0)" ::: "memory");
            const unsigned og = xb_add(&bar[XB_TOP], 1u);
            const unsigned tg = og / nx;
            if (og + 1u == (tg + 1u) * nx) xb_add(&bar[XB_TOPGEN], 1u);
            else XB_SPIN(xb_ld(&bar[XB_TOPGEN]) == tg, bar);
            __builtin_amdgcn_fence(__ATOMIC_ACQUIRE, "agent");
            xb_add(&bar[XB_XGEN(b.x)], 1u);
            asm volatile("s_waitcnt vmcnt(0)" ::: "memory");
        } else {
            XB_SPIN(xb_ld(&bar[XB_XGEN(b.x)]) == gen, bar);
            __builtin_amdgcn_fence(__ATOMIC_ACQUIRE, "agent");
            asm volatile("s_waitcnt vmcnt(0)" ::: "memory");
        }
    }
    __syncthreads();
}

struct Args { const float* in[19]; float* out; unsigned char* ws; int ph_lo, ph_hi; };
struct Frame {
    LAS unsigned char* lds;
    int tid, lane, wave, G, vcu;
    const float* in[19]; float* out; unsigned char* ws;
};
__device__ __forceinline__ float wave_sum(float v) {
#pragma unroll
    for (int o = 1; o < 64; o <<= 1) v += __shfl_xor(v, o);
    return v;
}

constexpr bool ProbOutQ = (FP8_OUT != 0) && ((FAST_GEMM & 2) != 0) && (FAST_HGRN != 0) && (HGRN_SEG != 0);
constexpr bool ProbE1Q = (FP8_E1 != 0) && ((FAST_GEMM & 4) != 0), ProbE2Q = (FP8_E2 != 0) && ((FAST_GEMM & 8) != 0) && ((FAST_GEMM & 4) != 0);
struct P0Item { const float* W; bf16* WT; const float* kscale; int K, N, k0, n0, orow0, q8; float qs; };
__device__ __forceinline__ void p0_item(Frame& F, int it, P0Item& I) {
    bf16* WinT = (bf16*)(F.ws + WS_WIN); bf16* WoutT = (bf16*)(F.ws + WS_WOUT); bf16* WrT = (bf16*)(F.ws + WS_WR);
    bf16* WGU = (bf16*)((unsigned char*)F.out + OUT_WGU); bf16* WD = (bf16*)((unsigned char*)F.out + OUT_WD);
    constexpr int I_IN = 16 * 112, I_OUT = 16 * 32, I_R = 16 * 2, I_E = 384;
    int r = it;
    if (r < I_IN) { I.W = F.in[3]; I.q8 = 0; I.WT = WinT; I.kscale = F.in[2]; I.K = D; I.N = PW; I.k0 = 64 * (r / 112); I.n0 = 32 * (r % 112); I.orow0 = I.n0; return; } r -= I_IN;
    if (r < I_OUT) { I.W = F.in[8]; I.q8 = ProbOutQ ? 1 : 0; I.qs = WQ_SCALE; I.WT = WoutT; I.kscale = nullptr; I.K = D; I.N = D; I.k0 = 64 * (r / 32); I.n0 = 32 * (r % 32); I.orow0 = I.n0; return; } r -= I_OUT;
    if (r < I_R) { I.W = F.in[10]; I.q8 = 0; I.WT = WrT; I.kscale = F.in[9]; I.K = D; I.N = NE; I.k0 = 64 * (r / 2); I.n0 = 32 * (r % 2); I.orow0 = I.n0; return; } r -= I_R;
    const int e = r / I_E, q = r % I_E, kind = q / 128, idx = q % 128;
    if (kind < 2) {
        I.W = (e < NE) ? (kind == 0 ? F.in[12] : F.in[13]) + (size_t)e * D * FF : (kind == 0 ? F.in[15] : F.in[16]);
        I.q8 = ProbE1Q ? 1 : 0; I.qs = WQ_SCALE; I.WT = ProbE1Q ? (bf16*)((unsigned char*)WGU + (size_t)e * 512 * D) : WGU + (size_t)e * 512 * D; I.kscale = F.in[9]; I.K = D; I.N = FF; I.k0 = 64 * (idx / 8); I.n0 = 32 * (idx % 8); I.orow0 = (I.n0 / 128) * 256 + (kind == 1 ? 128 : 0) + (I.n0 % 128);
    } else {
        I.W = (e < NE) ? F.in[14] + (size_t)e * FF * D : F.in[17];
        I.q8 = ProbE2Q ? 1 : 0; I.qs = WDQ_SCALE; I.WT = ProbE2Q ? (bf16*)((unsigned char*)WD + (size_t)e * D * FF) : WD + (size_t)e * D * FF; I.kscale = nullptr; I.K = FF; I.N = D; I.k0 = 64 * (idx / 32); I.n0 = 32 * (idx % 32); I.orow0 = I.n0;
    }
}
__device__ __forceinline__ void p0_load(const P0Item& I, int lane, f32x4 (&v)[8]) {
#pragma unroll
    for (int i = 0; i < 8; ++i) { const int kk = 8 * i + (lane >> 3); v[i] = __builtin_nontemporal_load((const f32x4*)(I.W + (size_t)(I.k0 + kk) * I.N + I.n0 + 4 * (lane & 7))); }
}
__device__ __forceinline__ void p0_store(const P0Item& I, int lane, f32x4 (&v)[8], LAS float* scr) {
    if (I.kscale) {
#pragma unroll
        for (int i = 0; i < 8; ++i) v[i] *= I.kscale[I.k0 + 8 * i + (lane >> 3)];
    }
#pragma unroll
    for (int i = 0; i < 8; ++i) { LAS float* d = scr + (8 * i + (lane >> 3)) * 33 + 4 * (lane & 7); d[0] = v[i][0]; d[1] = v[i][1]; d[2] = v[i][2]; d[3] = v[i][3]; }
    LDS_WAIT(); asm volatile("" ::: "memory");
    if (I.q8) {
        const int c = lane & 3;
#pragma unroll
        for (int j = 0; j < 2; ++j) { const int n = (lane >> 2) + 16 * j; const LAS float* s = scr + (16 * c) * 33 + n; unsigned w[4];
#pragma unroll
            for (int q = 0; q < 4; ++q) { int t = __builtin_amdgcn_cvt_pk_fp8_f32(s[(4 * q) * 33] * I.qs, s[(4 * q + 1) * 33] * I.qs, 0, false); t = __builtin_amdgcn_cvt_pk_fp8_f32(s[(4 * q + 2) * 33] * I.qs, s[(4 * q + 3) * 33] * I.qs, t, true); w[q] = (unsigned)t; }
            __builtin_nontemporal_store((v4u){w[0], w[1], w[2], w[3]}, (v4u*)((unsigned char*)I.WT + (size_t)(I.orow0 + n) * I.K + I.k0 + 16 * c)); }
    } else {
    const int c = lane & 7;
#pragma unroll
    for (int j = 0; j < 4; ++j) { const int n = (lane >> 3) + 8 * j; const LAS float* s = scr + (8 * c) * 33 + n;
        v4u o; o.x = pk2(s[0 * 33], s[1 * 33]); o.y = pk2(s[2 * 33], s[3 * 33]); o.z = pk2(s[4 * 33], s[5 * 33]); o.w = pk2(s[6 * 33], s[7 * 33]);
        *(v4u*)(I.WT + (size_t)(I.orow0 + n) * I.K + I.k0 + 8 * c) = o; }
    }
    LDS_WAIT(); asm volatile("" ::: "memory");
}
__device__ __forceinline__ void p0_xn_row(Frame& F, int m, bf16* XN, int lane) {
    v2u* o8 = (v2u*)(XN + (size_t)m * D) + lane;
    if (m >= NTOK + NMETA) {
#pragma unroll
        for (int j = 0; j < 4; ++j) o8[64 * j] = (v2u){0u, 0u};
        return;
    }
    const float* xrow = (m < NTOK) ? F.in[0] + (size_t)m * D : F.in[1] + (size_t)(m - NTOK) * D;
    const f32x4* xr = (const f32x4*)xrow + lane;
    f32x4 v[4]; float s = 0.f;
#pragma unroll
    for (int j = 0; j < 4; ++j) { v[j] = __builtin_nontemporal_load(xr + 64 * j); s += (v[j].x * v[j].x + v[j].y * v[j].y) + (v[j].z * v[j].z + v[j].w * v[j].w); }
    const float ms = wave_sum(s) * (1.f / D) + EPS, rstd = rsqf_(ms);
    if (m < NTOK && lane == 0) ((float*)(F.ws + WS_RINV))[m] = ms * rstd;
#pragma unroll
    for (int j = 0; j < 4; ++j) o8[64 * j] = (v2u){pk2(v[j].x * rstd, v[j].y * rstd), pk2(v[j].z * rstd, v[j].w * rstd)};
}
constexpr int P0_NONEXPERT = 16 * 112 + 16 * 32 + 16 * 2, P0_NITEMS = P0_NONEXPERT + 65 * 384;
__device__ __forceinline__ void p0_convert(Frame& F, int lo, int hi, int gw, int NGW) {
    LAS float* scr = (LAS float*)(F.lds + F.wave * 16384); const int lane = F.lane;
    if (lo + gw >= hi) return;
    P0Item cur, nxt; f32x4 va[8], vb[8];
    p0_item(F, lo + gw, cur); p0_load(cur, lane, va);
    for (int it = lo + gw; it < hi; it += 2 * NGW) {
        const bool h1 = it + NGW < hi;
        if (h1) { p0_item(F, it + NGW, nxt); p0_load(nxt, lane, vb); }
        p0_store(cur, lane, va, scr);
        const bool h2 = it + 2 * NGW < hi;
        if (h2) { p0_item(F, it + 2 * NGW, cur); p0_load(cur, lane, va); }
        if (h1) p0_store(nxt, lane, vb, scr);
    }
}
__device__ __forceinline__ void meta_proj(Frame& F, int gw, int NGW) {
    const bf16* XN = (const bf16*)(F.ws + WS_XN); const bf16* W = (const bf16*)(F.ws + WS_WIN); bf16* PROJ = (bf16*)(F.ws + WS_PROJ);
    const int lane = F.lane, fr = lane & 15, fq = lane >> 4;
    for (int nt = gw; nt < PW / 16; nt += NGW) {
        f32x4 acc = {0.f, 0.f, 0.f, 0.f};
        const bf16* ap = XN + (size_t)(NTOK + fr) * D + 8 * fq; const bf16* bp = W + (size_t)(16 * nt + fr) * D + 8 * fq;
#pragma unroll 8
        for (int k0 = 0; k0 < D; k0 += 32) acc = __builtin_amdgcn_mfma_f32_16x16x32_bf16(*(const bf16x8*)(ap + k0), *(const bf16x8*)(bp + k0), acc, 0, 0, 0);
#pragma unroll
        for (int j = 0; j < 4; ++j) PROJ[(size_t)(NTOK + 4 * fq + j) * PW + 16 * nt + fr] = (bf16)f2bf(acc[j]);
    }
}
__device__ __forceinline__ void p0_prologue(Frame& F) {
    const int gw = F.vcu * NWAVES + F.wave, NGW = F.G * NWAVES, lane = F.lane;
    bf16* XN = (bf16*)(F.ws + WS_XN);
    for (int m = gw; m < MROWS; m += NGW) p0_xn_row(F, m, XN, lane);
    p0_convert(F, 0, (GEMM_CUS_CFG >= 256) ? P0_NITEMS : P0_NONEXPERT + P0_SPLIT, gw, NGW);
    if (blockIdx.x == 0) {
        float* LB = (float*)(F.ws + WS_LB);
        const float t0 = F.in[4][F.tid], t1 = F.in[4][HW + F.tid];
        LB[F.tid] = 1.f / (1.f + fexp_(t1 - t0));
    }
}

struct Unit { int pm, pn, e, rows; };
struct MoeTab { LAS int* cnt; LAS int* rowbase; LAS int* tb; };
__device__ __forceinline__ void moe_build_tab(Frame& F, MoeTab& T) {
    T.cnt = (LAS int*)(F.lds + TAB_OFF); T.rowbase = T.cnt + 64; T.tb = T.rowbase + 65;
    if (F.tid < NE) {
        const unsigned* counts = (const unsigned*)(F.ws + WS_CTL) + CW_CNT;
        const int c = (int)__hip_atomic_load(counts + F.tid, __ATOMIC_RELAXED, __HIP_MEMORY_SCOPE_AGENT), t = (c + 255) >> 8;
        int rb = c, tb = t;
#pragma unroll
        for (int o = 1; o < 64; o <<= 1) { const int a = __shfl_up(rb, o), b = __shfl_up(tb, o); if (F.lane >= o) { rb += a; tb += b; } }
        T.cnt[F.tid] = c; T.rowbase[F.tid] = rb - c; T.tb[F.tid] = tb - t;
        if (F.tid == NE - 1) { T.rowbase[NE] = rb; T.tb[NE] = tb; }
    }
    __syncthreads();
}
__device__ __forceinline__ void moe_tile(const MoeTab& T, int tile, Unit& u) {
    if (tile < 128) { u.e = NE; u.pm = tile * 256; u.rows = 256; return; }
    const int t = tile - 128; int lo = 0, hi = NE - 1;
    while (lo < hi) { const int mid = (lo + hi + 1) >> 1; if (T.tb[mid] <= t) lo = mid; else hi = mid - 1; }
    u.e = lo; const int rt = t - T.tb[lo]; u.pm = rt * 256; const int left = T.cnt[lo] - rt * 256; u.rows = left < 256 ? left : 256;
}
__device__ __forceinline__ void dense_unit(int L, int nM, int nN, Unit& u) {
    const int nwg = nM * nN; int wgid = L; { const int q = nwg / 8, r = nwg % 8, xcd = wgid % 8, off = wgid / 8; wgid = (xcd < r ? xcd * (q + 1) : r * (q + 1) + (xcd - r) * q) + off; }
    const int nig = 8 * nN, gid = wgid / nig, fm = gid * 8, gsz = (nM - fm) < 8 ? (nM - fm) : 8;
    u.pm = fm + ((wgid % nig) % gsz); u.pn = (wgid % nig) / gsz; u.e = 0; u.rows = 256;
}
__device__ __forceinline__ unsigned cvt_pk_bf16(float lo, float hi) { unsigned r; asm volatile("v_cvt_pk_bf16_f32 %0, %1, %2" : "=v"(r) : "v"(lo), "v"(hi)); return r; }
__device__ __forceinline__ v4u pack8(const f32x4& a, const f32x4& b) { v4u w; w.x = cvt_pk_bf16(a[0], a[1]); w.y = cvt_pk_bf16(a[2], a[3]); w.z = cvt_pk_bf16(b[0], b[1]); w.w = cvt_pk_bf16(b[2], b[3]); return w; }
typedef f32x4 AccT[2][2][4][2];
__device__ __forceinline__ int bcol_wide(int bj, int slot) { const int wc = slot >> 5, rho = slot & 31, n = rho >> 4, i = rho & 15; return 64 * wc + 16 * (i >> 2) + 8 * bj + 4 * n + (i & 3); }
__device__ __forceinline__ int bcol_split(int bj, int slot) { const int wc = slot >> 5, rho = slot & 31, n = rho >> 4, i = rho & 15; return 64 * wc + 32 * bj + 8 * (i >> 2) + 4 * n + (i & 3); }
__device__ __forceinline__ int bcol_pair(int bj, int slot) { const int rho = slot & 31, n = rho >> 4, i = rho & 15; return 128 * bj + (slot & ~31) + 8 * (i >> 2) + 4 * n + (i & 3); }

#ifndef OUT_NT
#define OUT_NT 0
#endif
#if OUT_NT
#define OUT_STORE(v, p) __builtin_nontemporal_store((v), (p))
#else
#define OUT_STORE(v, p) (*(p) = (v))
#endif
#ifndef PROJ_NT
#define PROJ_NT 1
#endif
#if PROJ_NT
#define PROJ_STORE(v, p) __builtin_nontemporal_store((v), (p))
#else
#define PROJ_STORE(v, p) (*(p) = (v))
#endif
struct ProbIn {
    static constexpr int K = D; static constexpr bool PAIR = false, RAW_BX = true, FP8 = false; static constexpr int MSCALE = 127;
    const bf16* XN; const bf16* W; bf16* PROJ;
    __device__ __forceinline__ int nunits() const { return 128 * 14; }
    __device__ __forceinline__ void unit(int L, Unit& u, int = -1) const { dense_unit(L, 128, 14, u); }
    __device__ __forceinline__ const bf16* arow(const Unit& u, int r) const { return XN + (size_t)(u.pm * 256 + r) * D; }
    __device__ __forceinline__ const bf16* brow(const Unit& u, int c) const { return W + (size_t)(u.pn * 256 + c) * D; }
    __device__ __forceinline__ void store(const Unit& u, int r, int c, float v) const { PROJ[(size_t)(u.pm * 256 + r) * PW + u.pn * 256 + c] = (bf16)f2bf(v); }
    __device__ __forceinline__ const char* abase() const { return (const char*)XN; }
    __device__ __forceinline__ unsigned aoff(const Unit& u, int, int r, int c) const { return (unsigned)((u.pm * 256 + r) * D + c) * 2u; }
    __device__ __forceinline__ const char* bbase(const Unit& u) const { return (const char*)(W + (size_t)u.pn * 256 * D); }
    static __device__ __forceinline__ int bcol(int bj, int slot) { return bcol_split(bj, slot); }
    __device__ __forceinline__ void epi(const AccT& acc, const Unit& u, int wr, int wc, int fr, int fq) const {
#pragma unroll
        for (int ai = 0; ai < 2; ++ai)
#pragma unroll
            for (int m = 0; m < 4; ++m) {
                const v4u w0 = pack8(acc[ai][0][m][0], acc[ai][0][m][1]), w1 = pack8(acc[ai][1][m][0], acc[ai][1][m][1]);
                const bool odd = fr & 1;
                const v4u snd = odd ? w0 : w1; v4u rcv;
                rcv.x = (unsigned)__builtin_amdgcn_mov_dpp((int)snd.x, 0xB1, 0xF, 0xF, true); rcv.y = (unsigned)__builtin_amdgcn_mov_dpp((int)snd.y, 0xB1, 0xF, 0xF, true);
                rcv.z = (unsigned)__builtin_amdgcn_mov_dpp((int)snd.z, 0xB1, 0xF, 0xF, true); rcv.w = (unsigned)__builtin_amdgcn_mov_dpp((int)snd.w, 0xB1, 0xF, 0xF, true);
                bf16* rowp = PROJ + (size_t)(u.pm * 256 + 128 * ai + 64 * wr + 16 * m + (fr & ~1)) * PW + u.pn * 256 + 64 * wc + 8 * fq + (odd ? 32 : 0);
                PROJ_STORE(odd ? rcv : w0, (v4u*)rowp); PROJ_STORE(odd ? w1 : rcv, (v4u*)(rowp + PW)); }
    }
};
struct ProbOut {
    static constexpr bool PAIR = false, RAW_BX = true, FP8 = ProbOutQ; static constexpr int MSCALE = FP8 ? 122 : 127;
    static constexpr int K = FP8 ? D / 2 : D;
    const bf16* Y; const bf16* W; const float* x; bf16* H1; float* sumsq; unsigned char* H1q; const bf16* XNr; const float* rinv;
    __device__ __forceinline__ int nunits() const { return 128 * 4; }
    __device__ __forceinline__ void unit(int L, Unit& u, int = -1) const { dense_unit(L, 128, 4, u); }
    __device__ __forceinline__ const bf16* arow(const Unit& u, int r) const { return Y + (size_t)(u.pm * 256 + r) * D; }
    __device__ __forceinline__ const bf16* brow(const Unit& u, int c) const { return W + (size_t)(u.pn * 256 + c) * D; }
    __device__ __forceinline__ const char* abase() const { return (const char*)Y; }
    __device__ __forceinline__ unsigned aoff(const Unit& u, int, int r, int c) const { return (unsigned)((u.pm * 256 + r) * K + c) * 2u; }
    __device__ __forceinline__ const char* bbase(const Unit& u) const { return (const char*)(W + (size_t)u.pn * 256 * K); }
    static __device__ __forceinline__ int bcol(int bj, int slot) { return bcol_split(bj, slot); }
    static __device__ __forceinline__ v4u swap4(const v4u& a) { v4u r; r.x = (unsigned)__builtin_amdgcn_mov_dpp((int)a.x, 0xB1, 0xF, 0xF, true); r.y = (unsigned)__builtin_amdgcn_mov_dpp((int)a.y, 0xB1, 0xF, 0xF, true);
        r.z = (unsigned)__builtin_amdgcn_mov_dpp((int)a.z, 0xB1, 0xF, 0xF, true); r.w = (unsigned)__builtin_amdgcn_mov_dpp((int)a.w, 0xB1, 0xF, 0xF, true); return r; }
    __device__ __forceinline__ void epi(const AccT& acc, const Unit& u, int wr, int wc, int fr, int fq) const {
        const bool odd = fr & 1;
        v4u lav[2][4], lbv[2][4]; float riv[2][4];
#pragma unroll
        for (int ai = 0; ai < 2; ++ai)
#pragma unroll
            for (int m = 0; m < 4; ++m) {
                const int rowe = u.pm * 256 + 128 * ai + 64 * wr + 16 * m + (fr & ~1), row = rowe + (odd ? 1 : 0);
                const unsigned ob = ((unsigned)rowe * D + u.pn * 256 + 64 * wc + 8 * fq + (odd ? 32 : 0)) * 2u;
                riv[ai][m] = rinv[row]; lav[ai][m] = *(const v4u*)((const char*)XNr + ob); lbv[ai][m] = *(const v4u*)((const char*)XNr + ob + 2 * D); }
#pragma unroll
        for (int ai = 0; ai < 2; ++ai)
#pragma unroll
            for (int m = 0; m < 4; ++m) {
                const int rowe = u.pm * 256 + 128 * ai + 64 * wr + 16 * m + (fr & ~1), row = rowe + (odd ? 1 : 0);
                const size_t oe = (size_t)rowe * D + u.pn * 256 + 64 * wc + 8 * fq + (odd ? 32 : 0);
                const float ri = riv[ai][m];
                const v4u la = lav[ai][m], lb = lbv[ai][m];
                const v4u xr = swap4(odd ? la : lb);
                const v4u xw[2] = {odd ? xr : la, odd ? lb : xr};
                float ss = 0.f; v4u hw[2]; v2u q8[2];
#pragma unroll
                for (int bj = 0; bj < 2; ++bj) {
                    const f32x4 x0 = (f32x4){bflo(xw[bj].x), bfhi(xw[bj].x), bflo(xw[bj].y), bfhi(xw[bj].y)} * ri, x1 = (f32x4){bflo(xw[bj].z), bfhi(xw[bj].z), bflo(xw[bj].w), bfhi(xw[bj].w)} * ri;
                    const f32x4 v0 = acc[ai][bj][m][0] + x0, v1 = acc[ai][bj][m][1] + x1;
                    ss += (v0[0] * v0[0] + v0[1] * v0[1]) + (v0[2] * v0[2] + v0[3] * v0[3]) + (v1[0] * v1[0] + v1[1] * v1[1]) + (v1[2] * v1[2] + v1[3] * v1[3]);
                    hw[bj] = pack8(v0, v1);
                    if (H1q) { int w0 = __builtin_amdgcn_cvt_pk_fp8_f32(v0[0], v0[1], 0, false); w0 = __builtin_amdgcn_cvt_pk_fp8_f32(v0[2], v0[3], w0, true);
                        int w1 = __builtin_amdgcn_cvt_pk_fp8_f32(v1[0], v1[1], 0, false); w1 = __builtin_amdgcn_cvt_pk_fp8_f32(v1[2], v1[3], w1, true);
                        q8[bj] = (v2u){(unsigned)w0, (unsigned)w1}; }
                }
                { const v4u hr = swap4(odd ? hw[0] : hw[1]);
                  *(v4u*)(H1 + oe) = odd ? hr : hw[0]; *(v4u*)(H1 + oe + D) = odd ? hw[1] : hr; }
                if (H1q) { const v2u qs = odd ? q8[0] : q8[1]; v2u qr; qr.x = (unsigned)__builtin_amdgcn_mov_dpp((int)qs.x, 0xB1, 0xF, 0xF, true); qr.y = (unsigned)__builtin_amdgcn_mov_dpp((int)qs.y, 0xB1, 0xF, 0xF, true);
                  *(v2u*)(H1q + oe) = odd ? qr : q8[0]; *(v2u*)(H1q + oe + D) = odd ? q8[1] : qr; }
                ss += __shfl_xor(ss, 16); ss += __shfl_xor(ss, 32);
                if (fq == 0) atomicAdd(sumsq + row, ss);
            }
    }
};
struct ProbE1 {
    static constexpr bool FP8 = (FP8_E1 != 0) && ((FAST_GEMM & 4) != 0), PAIR = true, RAW_BX = false;
    static constexpr int MSCALE = 122;
    static_assert(WQ_SCALE == 32.f, "MSCALE assumes WQ_SCALE = 32");
    static constexpr int K = FP8 ? D / 2 : D;
    MoeTab T; const bf16* H1; const bf16* WGU; const int* tok; const f32x2* scl; const f32x2* scls; bf16* HID; LAS int* idx;
    __device__ __forceinline__ int nunits() const { return (128 + T.tb[NE]) * 2; }
    LAS int* ut = nullptr;
    __device__ __forceinline__ void unit(int i, Unit& u, int slot = -1) const { if (slot >= 0 && ut) { const LAS int* q = ut + 4 * slot; u.e = q[0]; u.pm = q[1]; u.rows = q[2]; u.pn = q[3]; return; } moe_tile(T, i >> 1, u); u.pn = i & 1; }
    __device__ __forceinline__ int token(const Unit& u, int r) const { if (u.e == NE) return u.pm + r; const int rr = (r < u.rows) ? u.pm + r : u.pm; return tok[(size_t)u.e * NTOK + rr]; }
    __device__ __forceinline__ const bf16* arow(const Unit& u, int r) const { return H1 + (size_t)token(u, r) * D; }
    __device__ __forceinline__ const bf16* brow(const Unit& u, int c) const { return WGU + ((size_t)u.e * 512 + u.pn * 256 + c) * D; }
    __device__ __forceinline__ size_t hidrow(const Unit& u, int r) const { return (u.e == NE) ? (size_t)(u.pm + r) : (size_t)(NTOK + T.rowbase[u.e] + u.pm + r); }
    __device__ __forceinline__ f32x2 scale(const Unit& u, int r) const { return (u.e == NE) ? scls[u.pm + r] : scl[(size_t)u.e * NTOK + u.pm + r]; }
    __device__ __forceinline__ void store2(const Unit& u, int r, int c, float g, float up) const {
        if (r >= u.rows) return;
        const f32x2 sc = scale(u, r);
        HID[hidrow(u, r) * FF + u.pn * 128 + c] = (bf16)f2bf(siluf_(g * sc.x) * up * sc.y);
    }
    __device__ __forceinline__ const char* abase() const { return (const char*)H1; }
    __device__ __forceinline__ unsigned aoff(const Unit& u, int slot, int r, int c) const { const int t = (u.e == NE) ? u.pm + r : idx[slot * 256 + r]; return (unsigned)(t * K + c) * 2u; }
    __device__ __forceinline__ const char* bbase(const Unit& u) const { return (const char*)WGU + ((size_t)u.e * 512 + u.pn * 256) * K * 2; }
    static __device__ __forceinline__ int bcol(int bj, int slot) { return bcol_pair(bj, slot); }
    __device__ __forceinline__ void epi(const AccT& acc, const Unit& u, int wr, int wc, int fr, int fq) const {
        const size_t hb = hidrow(u, 0);
        f32x2 scv[2][4];
#pragma unroll
        for (int ai = 0; ai < 2; ++ai)
#pragma unroll
            for (int m = 0; m < 4; ++m) { const int r = 128 * ai + 64 * wr + 16 * m + fr; scv[ai][m] = scale(u, r < u.rows ? r : u.rows - 1); }
        __builtin_amdgcn_s_waitcnt(0x0F70);
#pragma unroll
        for (int ai = 0; ai < 2; ++ai)
#pragma unroll
            for (int m = 0; m < 4; ++m) {
                const int r = 128 * ai + 64 * wr + 16 * m + fr;
                {
                    f32x2 sc = scv[ai][m]; if (ProbE2Q) sc.y *= HQ_SCALE;
                    f32x4 h0, h1;
#pragma unroll
                    for (int j = 0; j < 4; ++j) { h0[j] = siluf_(acc[ai][0][m][0][j] * sc.x) * acc[ai][1][m][0][j] * sc.y; h1[j] = siluf_(acc[ai][0][m][1][j] * sc.x) * acc[ai][1][m][1][j] * sc.y; }
                    if (ProbE2Q) {
#pragma unroll
                        for (int j = 0; j < 4; ++j) { h0[j] = __builtin_amdgcn_fmed3f(h0[j], -F8MAX, F8MAX); h1[j] = __builtin_amdgcn_fmed3f(h1[j], -F8MAX, F8MAX); }
                        int w0 = __builtin_amdgcn_cvt_pk_fp8_f32(h0[0], h0[1], 0, false); w0 = __builtin_amdgcn_cvt_pk_fp8_f32(h0[2], h0[3], w0, true);
                        int w1 = __builtin_amdgcn_cvt_pk_fp8_f32(h1[0], h1[1], 0, false); w1 = __builtin_amdgcn_cvt_pk_fp8_f32(h1[2], h1[3], w1, true);
                        if (r < u.rows) *(v2u*)((unsigned char*)HID + (hb + r) * FF + u.pn * 128 + 32 * wc + 8 * fq) = (v2u){(unsigned)w0, (unsigned)w1}; }
                    else if (r < u.rows) *(v4u*)(HID + (hb + r) * FF + u.pn * 128 + 32 * wc + 8 * fq) = pack8(h0, h1);
                }
            }
    }
};
struct ProbE2 {
    static constexpr bool PAIR = false, RAW_BX = false, FP8 = ProbE2Q;
    static constexpr int MSCALE = FP8 ? 124 : 127;
    static_assert(YSCALE * 8.f == HQ_SCALE * WDQ_SCALE, "MSCALE assumes YSCALE / (HQ_SCALE * WDQ_SCALE) = 1/8");
    static constexpr int K = FP8 ? FF / 2 : FF;
    MoeTab T; const bf16* HID; const bf16* WD; unsigned char* YS; unsigned char* YR; int t0; int ntl;
    __device__ __forceinline__ int nunits() const { return (ntl > 0 ? ntl : 128 - t0 + T.tb[NE]) * 4; }
    LAS int* ut = nullptr;
    __device__ __forceinline__ void unit(int i, Unit& u, int slot = -1) const { if (slot >= 0 && ut) { const LAS int* q = ut + 4 * slot; u.e = q[0]; u.pm = q[1]; u.rows = q[2]; u.pn = q[3]; return; } moe_tile(T, (i >> 2) + t0, u); u.pn = i & 3; }
    __device__ __forceinline__ size_t hidrow(const Unit& u, int r) const { return (u.e == NE) ? (size_t)(u.pm + r) : (size_t)(NTOK + T.rowbase[u.e] + u.pm + r); }
    __device__ __forceinline__ const bf16* arow(const Unit& u, int r) const { return HID + hidrow(u, r) * FF; }
    __device__ __forceinline__ const bf16* brow(const Unit& u, int c) const { return WD + ((size_t)u.e * D + u.pn * 256 + c) * FF; }
    __device__ __forceinline__ void store(const Unit& u, int r, int c, float v) const {
        if (r >= u.rows) return;
        if (u.e == NE) { const int w = __builtin_amdgcn_cvt_pk_fp8_f32(v * YSCALE, 0.f, 0, false); YS[(size_t)(u.pm + r) * D + u.pn * 256 + c] = (unsigned char)(w & 0xff); }
        else { const int w = __builtin_amdgcn_cvt_pk_fp8_f32(v * YSCALE, 0.f, 0, false); YR[(size_t)(T.rowbase[u.e] + u.pm + r) * D + u.pn * 256 + c] = (unsigned char)(w & 0xff); }
    }
    __device__ __forceinline__ const char* abase() const { return (const char*)HID; }
    __device__ __forceinline__ unsigned aoff(const Unit& u, int, int r, int c) const { return (unsigned)(((unsigned)hidrow(u, 0) + (unsigned)r) * K + c) * 2u; }
    __device__ __forceinline__ const char* bbase(const Unit& u) const { return (const char*)WD + ((size_t)u.e * D + u.pn * 256) * K * 2; }
    static __device__ __forceinline__ int bcol(int bj, int slot) { return bcol_wide(bj, slot); }
    __device__ __forceinline__ void epi(const AccT& acc, const Unit& u, int wr, int wc, int fr, int fq) const {
        const int cb = u.pn * 256 + 64 * wc + 16 * fq;
        constexpr float dq = FP8 ? 1.f / (HQ_SCALE * WDQ_SCALE) : 1.f;
        unsigned char* yb = (u.e == NE) ? YS : YR; const int row0 = (u.e == NE) ? u.pm : T.rowbase[u.e] + u.pm;
#pragma unroll
        for (int ai = 0; ai < 2; ++ai)
#pragma unroll
            for (int m = 0; m < 4; ++m) {
                const int r = 128 * ai + 64 * wr + 16 * m + fr;
                if (r < u.rows) {
                    v4u w;
#pragma unroll
                    for (int bj = 0; bj < 2; ++bj) { f32x4 v0 = acc[ai][bj][m][0], v1 = acc[ai][bj][m][1]; if (!FP8) { v0 *= YSCALE; v1 *= YSCALE; }
#pragma unroll
                        for (int j = 0; j < 4; ++j) { v0[j] = __builtin_amdgcn_fmed3f(v0[j], -F8MAX, F8MAX); v1[j] = __builtin_amdgcn_fmed3f(v1[j], -F8MAX, F8MAX); }
                        int w0 = __builtin_amdgcn_cvt_pk_fp8_f32(v0[0], v0[1], 0, false); w0 = __builtin_amdgcn_cvt_pk_fp8_f32(v0[2], v0[3], w0, true);
                        int w1 = __builtin_amdgcn_cvt_pk_fp8_f32(v1[0], v1[1], 0, false); w1 = __builtin_amdgcn_cvt_pk_fp8_f32(v1[2], v1[3], w1, true);
                        if (bj == 0) { w.x = (unsigned)w0; w.y = (unsigned)w1; } else { w.z = (unsigned)w0; w.w = (unsigned)w1; } }
                    __builtin_nontemporal_store(w, (v4u*)(yb + (size_t)(row0 + r) * D + cb));
                }
            }
    }
};

template <class P>
__device__ __forceinline__ void simple_gemm_phase(Frame& F, const P& p, int Geff = 0) {
    const int lane = F.lane, fr = lane & 15, fq = lane >> 4, w = F.wave;
    const int nu = p.nunits();
    const int G = Geff ? Geff : F.G, c0 = (P::RAW_BX ? (int)blockIdx.x : F.vcu);
    if (c0 >= G) return;
    for (int i = c0; i < nu; i += G) {
        Unit u; p.unit(i, u);
        f32x4 acc[2][16];
#pragma unroll
        for (int a = 0; a < 2; ++a)
#pragma unroll
            for (int n = 0; n < 16; ++n) acc[a][n] = (f32x4){0.f, 0.f, 0.f, 0.f};
        const bf16* ap[2]; ap[0] = p.arow(u, 32 * w + fr) + 8 * fq; ap[1] = p.arow(u, 32 * w + 16 + fr) + 8 * fq;
        const bf16* bp = p.brow(u, fr) + 8 * fq;
        for (int k0 = 0; k0 < P::K; k0 += 32) {
            const bf16x8 a0 = *(const bf16x8*)(ap[0] + k0), a1 = *(const bf16x8*)(ap[1] + k0);
#pragma unroll
            for (int n = 0; n < 16; ++n) {
                const bf16x8 b = *(const bf16x8*)(bp + (size_t)(16 * n) * P::K + k0);
                acc[0][n] = __builtin_amdgcn_mfma_f32_16x16x32_bf16(a0, b, acc[0][n], 0, 0, 0);
                acc[1][n] = __builtin_amdgcn_mfma_f32_16x16x32_bf16(a1, b, acc[1][n], 0, 0, 0);
            }
        }
#pragma unroll
        for (int a = 0; a < 2; ++a)
#pragma unroll
            for (int j = 0; j < 4; ++j) {
                const int r = 32 * w + 16 * a + 4 * fq + j;
                if constexpr (P::PAIR) {
#pragma unroll
                    for (int n = 0; n < 8; ++n) p.store2(u, r, 16 * n + fr, acc[a][n][j], acc[a][n + 8][j]);
                } else {
#pragma unroll
                    for (int n = 0; n < 16; ++n) p.store(u, r, 16 * n + fr, acc[a][n][j]);
                }
            }
    }
}
__device__ __forceinline__ void simple_gemm_out(Frame& F, const ProbOut& p) {
    const int lane = F.lane, fr = lane & 15, fq = lane >> 4, w = F.wave;
    for (int i = blockIdx.x; i < p.nunits(); i += F.G) {
        Unit u; p.unit(i, u);
        f32x4 acc[2][16];
#pragma unroll
        for (int a = 0; a < 2; ++a)
#pragma unroll
            for (int n = 0; n < 16; ++n) acc[a][n] = (f32x4){0.f, 0.f, 0.f, 0.f};
        const bf16* ap0 = p.arow(u, 32 * w + fr) + 8 * fq; const bf16* ap1 = p.arow(u, 32 * w + 16 + fr) + 8 * fq;
        const bf16* bp = p.brow(u, fr) + 8 * fq;
        for (int k0 = 0; k0 < D; k0 += 32) {
            const bf16x8 a0 = *(const bf16x8*)(ap0 + k0), a1 = *(const bf16x8*)(ap1 + k0);
#pragma unroll
            for (int n = 0; n < 16; ++n) {
                const bf16x8 b = *(const bf16x8*)(bp + (size_t)(16 * n) * D + k0);
                acc[0][n] = __builtin_amdgcn_mfma_f32_16x16x32_bf16(a0, b, acc[0][n], 0, 0, 0);
                acc[1][n] = __builtin_amdgcn_mfma_f32_16x16x32_bf16(a1, b, acc[1][n], 0, 0, 0);
            }
        }
#pragma unroll
        for (int a = 0; a < 2; ++a)
#pragma unroll
            for (int j = 0; j < 4; ++j) {
                const int row = u.pm * 256 + 32 * w + 16 * a + 4 * fq + j;
                float ss = 0.f;
#pragma unroll
                for (int n = 0; n < 16; ++n) { const int col = u.pn * 256 + 16 * n + fr; const float v = p.x[(size_t)row * D + col] + acc[a][n][j]; p.H1[(size_t)row * D + col] = (bf16)f2bf(v); ss += v * v; }
                ss += __shfl_xor(ss, 1); ss += __shfl_xor(ss, 2); ss += __shfl_xor(ss, 4); ss += __shfl_xor(ss, 8);
                if (fr == 0) atomicAdd(p.sumsq + row, ss);
            }
    }
}

namespace fg {
constexpr int BK = 64, HALF = 128, HTB = HALF * BK * 2;
__device__ __forceinline__ int lds_byte(int r, int c) { const int st = (r >> 4) * 2 + (c >> 5), rr = r & 15, cc = c & 31, ob = rr * 64 + cc * 2; return st * 1024 + (ob ^ (((ob >> 9) & 1) << 5)); }
__device__ __forceinline__ void stage_rc(int b, int& R, int& C) { const int st = b / 1024, sb = b % 1024, swz = sb ^ (((sb >> 9) & 1) << 5); R = (st >> 1) * 16 + swz / 64; C = (st & 1) * 32 + (swz % 64) / 2; }
__device__ __forceinline__ int perm32(int rho) { const int n = rho >> 4, i = rho & 15; return 8 * (i >> 2) + 4 * n + (i & 3); }

typedef int v8i __attribute__((ext_vector_type(8)));
typedef int v4i __attribute__((ext_vector_type(4)));
__device__ __forceinline__ const char* uptr(const char* p) { const unsigned long long v = (unsigned long long)p; const unsigned lo = __builtin_amdgcn_readfirstlane((unsigned)v), hi = __builtin_amdgcn_readfirstlane((unsigned)(v >> 32)); return (const char*)(((unsigned long long)hi << 32) | lo); }
template <class P>
__device__ __forceinline__ void gemm_phase(Frame& F, const P& p, int Geff = 0) {
    constexpr int K = P::K, nt = K / BK;
    LAS unsigned char* lds = F.lds;
    const int tid = F.tid, wid = F.wave, lane = F.lane, wr = wid >> 2, wc = wid & 3, fr = lane & 15, fq = lane >> 4;
    const int nu = p.nunits(), c0 = P::RAW_BX ? (int)blockIdx.x : F.vcu, G = Geff ? Geff : F.G;
    if (c0 >= nu || c0 >= G) return;
    unsigned voffB[2][2];
#pragma unroll
    for (int i = 0; i < 2; ++i) { int R, C; stage_rc(tid * 16 + i * 8192, R, C);
#pragma unroll
        for (int bj = 0; bj < 2; ++bj) voffB[bj][i] = (unsigned)(P::bcol(bj, R) * K + C) * 2u; }
    constexpr size_t kstep = (size_t)(BK * 2);
    const unsigned ldsw = (unsigned)wid * 1024u;
    const int aoff = lds_byte(wr * 64 + fr, fq * 8), boff = lds_byte(wc * 32 + fr, fq * 8);
#define FG_SA(b, h) (((b) * 2 + (h)) * HTB)
#define FG_SB(b, h) ((4 + (b) * 2 + (h)) * HTB)
#define FG_STAGE(bufoff, gbase, voff) do { _Pragma("unroll") for (int _i = 0; _i < 2; ++_i) { unsigned _v = (voff)[_i]; asm volatile("" : "+v"(_v));     \
        __builtin_amdgcn_global_load_lds((const unsigned*)((const char*)(gbase) + _v), (LAS unsigned*)(lds + (bufoff) + ldsw + _i * 8192), 16, 0, 0); } } while (0)
#define FG_LDA(dst, b, h) do { _Pragma("unroll") for (int m = 0; m < 4; ++m) { dst[m].lo = *(const LAS v4i*)(lds + FG_SA(b, h) + aoff + m * 2048); dst[m].hi = *(const LAS v4i*)(lds + FG_SA(b, h) + aoff + m * 2048 + 1024); } } while (0)
#define FG_LDB(dst, b, h) do { _Pragma("unroll") for (int n = 0; n < 2; ++n) { dst[n].lo = *(const LAS v4i*)(lds + FG_SB(b, h) + boff + n * 2048); dst[n].hi = *(const LAS v4i*)(lds + FG_SB(b, h) + boff + n * 2048 + 1024); } } while (0)
#define FG_MMA(ai, bj, At, Bt) do { __builtin_amdgcn_s_setprio(1); _Pragma("unroll") for (int m = 0; m < 4; ++m) _Pragma("unroll") for (int n = 0; n < 2; ++n) { \
        if constexpr (P::FP8) acc[ai][bj][m][n] = __builtin_amdgcn_mfma_scale_f32_16x16x128_f8f6f4(Bt[n], At[m], acc[ai][bj][m][n], 0, 0, 0, P::MSCALE, 0, 127); \
        else { acc[ai][bj][m][n] = __builtin_amdgcn_mfma_f32_16x16x32_bf16(__builtin_bit_cast(bf16x8, (v4i)Bt[n].lo), __builtin_bit_cast(bf16x8, (v4i)At[m].lo), acc[ai][bj][m][n], 0, 0, 0); \
               acc[ai][bj][m][n] = __builtin_amdgcn_mfma_f32_16x16x32_bf16(__builtin_bit_cast(bf16x8, (v4i)Bt[n].hi), __builtin_bit_cast(bf16x8, (v4i)At[m].hi), acc[ai][bj][m][n], 0, 0, 0); } } __builtin_amdgcn_s_setprio(0); } while (0)
#define FG_WAIT_V(n) asm volatile("s_waitcnt vmcnt(" #n ")" ::: "memory")
#define FG_WAIT_L(n) asm volatile("s_waitcnt lgkmcnt(" #n ")" ::: "memory")
#define FG_BAR __builtin_amdgcn_s_barrier()
#define FG_SCHED __builtin_amdgcn_sched_barrier(0)
#define FG_AOFFS(dst, u, slot) do { int _t = tid; asm volatile("" : "+v"(_t)); _Pragma("unroll") for (int _i = 0; _i < 2; ++_i) { int _R, _C; stage_rc(_t * 16 + _i * 8192, _R, _C); \
        _Pragma("unroll") for (int _h = 0; _h < 2; ++_h) dst[_h][_i] = p.aoff(u, slot, 128 * _h + _R, _C); } } while (0)
    Unit cur, nxt; int ui = 0;
    p.unit(c0, cur, 0);
    cur.pm = __builtin_amdgcn_readfirstlane(cur.pm); cur.pn = __builtin_amdgcn_readfirstlane(cur.pn); cur.e = __builtin_amdgcn_readfirstlane(cur.e); cur.rows = __builtin_amdgcn_readfirstlane(cur.rows);
    unsigned cvo[2][2];
    FG_AOFFS(cvo, cur, 0);
    AccT acc;
#pragma unroll
    for (int a = 0; a < 2; ++a)
#pragma unroll
        for (int b = 0; b < 2; ++b)
#pragma unroll
            for (int m = 0; m < 4; ++m)
#pragma unroll
                for (int n = 0; n < 2; ++n) acc[a][b][m][n] = (f32x4){0.f, 0.f, 0.f, 0.f};
    v8i At[4], B0[2], B1[2];
    const char* const Ab = p.abase();
    const char* cB = p.bbase(cur);
    FG_STAGE(FG_SB(0, 0), cB, voffB[0]); FG_STAGE(FG_SB(0, 1), cB, voffB[1]); FG_STAGE(FG_SA(0, 0), Ab, cvo[0]); FG_STAGE(FG_SA(0, 1), Ab, cvo[1]);
    if (wr == 1) FG_BAR;
    FG_WAIT_V(2); FG_BAR;
    FG_STAGE(FG_SB(1, 0), cB + kstep, voffB[0]); FG_STAGE(FG_SA(1, 0), Ab + kstep, cvo[0]); FG_STAGE(FG_SB(1, 1), cB + kstep, voffB[1]);
    FG_WAIT_V(6); FG_BAR;
    for (;;) {
        const int nidx = c0 + (ui + 1) * G;
        const bool has_next = nidx < nu;
        const char* nB = cB;
        if (has_next) {
            p.unit(nidx, nxt, ui + 1);
            nxt.pm = __builtin_amdgcn_readfirstlane(nxt.pm); nxt.pn = __builtin_amdgcn_readfirstlane(nxt.pn); nxt.e = __builtin_amdgcn_readfirstlane(nxt.e); nxt.rows = __builtin_amdgcn_readfirstlane(nxt.rows);
            nB = p.bbase(nxt);
        }
#pragma unroll 1
        for (int t = 0; t < nt; t += 2) {
            const bool last = (t == nt - 2);
            const char* a1 = uptr(Ab + (size_t)(t + 1) * kstep);
            const char* a2 = uptr(last ? Ab : Ab + (size_t)(t + 2) * kstep); const char* b2 = uptr(last ? nB : cB + (size_t)(t + 2) * kstep);
            const char* a3 = uptr(a2 + kstep); const char* b3 = uptr(b2 + kstep);
            FG_LDB(B0, 0, 0); FG_LDB(B1, 0, 1); FG_SCHED; FG_LDA(At, 0, 0); FG_STAGE(FG_SA(1, 1), a1, cvo[1]);
            if (last && has_next) FG_AOFFS(cvo, nxt, ui + 1);
            FG_WAIT_V(8); FG_WAIT_L(0); FG_BAR; FG_MMA(0, 0, At, B0); FG_MMA(0, 1, At, B1); FG_BAR; FG_SCHED;
            FG_LDA(At, 0, 1); FG_STAGE(FG_SB(0, 0), b2, voffB[0]); FG_STAGE(FG_SB(0, 1), b2, voffB[1]); FG_STAGE(FG_SA(0, 0), a2, cvo[0]);
            FG_WAIT_V(8); FG_WAIT_L(0); FG_BAR; FG_MMA(1, 0, At, B0); FG_MMA(1, 1, At, B1); FG_BAR; FG_SCHED;
            FG_LDB(B0, 1, 0); FG_LDB(B1, 1, 1); FG_SCHED; FG_LDA(At, 1, 0); FG_STAGE(FG_SA(0, 1), a2, cvo[1]);
            FG_WAIT_V(8); FG_WAIT_L(0); FG_BAR; FG_MMA(0, 0, At, B0); FG_MMA(0, 1, At, B1); FG_BAR; FG_SCHED;
            FG_LDA(At, 1, 1); FG_STAGE(FG_SB(1, 0), b3, voffB[0]); FG_STAGE(FG_SB(1, 1), b3, voffB[1]); FG_STAGE(FG_SA(1, 0), a3, cvo[0]);
            FG_WAIT_V(8); FG_WAIT_L(0); FG_BAR; FG_MMA(1, 0, At, B0); FG_MMA(1, 1, At, B1); FG_BAR; FG_SCHED;
        }
        if (wr == 0) FG_BAR;
        { int lne = lane; asm volatile("" : "+v"(lne));
          p.epi(acc, cur, wr, wc, lne & 15, lne >> 4); }
        if (!has_next) break;
#pragma unroll
        for (int a = 0; a < 2; ++a)
#pragma unroll
            for (int b = 0; b < 2; ++b)
#pragma unroll
                for (int m = 0; m < 4; ++m)
#pragma unroll
                    for (int n = 0; n < 2; ++n) acc[a][b][m][n] = (f32x4){0.f, 0.f, 0.f, 0.f};
        cur = nxt; cB = nB; ++ui;
        if (wr == 1) FG_BAR;
    }
    FG_WAIT_V(0);
    FG_BAR;
#undef FG_SA
#undef FG_SB
#undef FG_STAGE
#undef FG_LDA
#undef FG_LDB
#undef FG_MMA
#undef FG_WAIT_V
#undef FG_WAIT_L
#undef FG_BAR
#undef FG_SCHED
#undef FG_AOFFS
}
}
namespace e2 {
typedef int v8i __attribute__((ext_vector_type(8)));
typedef int v4i __attribute__((ext_vector_type(4)));
__device__ __forceinline__ int sw(int row, int chunk) { return row * 256 + ((chunk ^ (row & 15)) << 4); }
struct Tile { int e, pm, rows; };
__device__ __forceinline__ void tile_of(const MoeTab& T, int tr, Tile& t) { Unit u; moe_tile(T, 128 + tr, u); t.e = __builtin_amdgcn_readfirstlane(u.e); t.pm = __builtin_amdgcn_readfirstlane(u.pm); t.rows = __builtin_amdgcn_readfirstlane(u.rows); }
__device__ __forceinline__ void load_a(v8i (&a)[2][2], const unsigned char* HIDq, const MoeTab& T, const Tile& t, int w, int lane) {
    const int fr = lane & 15, fq = lane >> 4; const char* base = fg::uptr((const char*)HIDq + (size_t)(NTOK + T.rowbase[t.e] + t.pm) * 256);
#pragma unroll
    for (int mt = 0; mt < 2; ++mt)
#pragma unroll
        for (int ks = 0; ks < 2; ++ks) { unsigned o = (unsigned)((32 * w + 16 * mt + fr) * 256 + 16 * (8 * ks + fq)); asm volatile("" : "+v"(o));
            a[mt][ks].lo = *(const v4i*)(base + o); a[mt][ks].hi = *(const v4i*)(base + o + 64); }
}
__device__ __forceinline__ void phase(Frame& F, const MoeTab& T, const unsigned char* HIDq, const unsigned char* WD8, unsigned char* YR, unsigned char* dump) {
    LAS unsigned char* L = F.lds; const int lane = F.lane, w = F.wave;
    const int ntr = T.tb[NE];
    if (F.vcu >= ntr) return;
    const int ntl = (ntr - F.vcu + F.G - 1) / F.G, nh = 8 * ntl;
    Tile cur, nxt; tile_of(T, F.vcu, cur); nxt = cur;
#define E2_STAGE_B(g, te) do { const int _hf = (g) & 7; const char* _bb = fg::uptr((const char*)WD8 + (size_t)(te) * D * 256); const int _rg = ln >> 4, _pc = ln & 15; \
        _Pragma("unroll") for (int i = 0; i < 4; ++i) { const int s = 16 * w + 4 * i + _rg, col = 32 * ((s & 15) >> 2) + 4 * (s >> 4) + (s & 3); \
            unsigned bo = (unsigned)((128 * _hf + col) * 256 + 16 * (_pc ^ (s & 15))); asm volatile("" : "+v"(bo)); \
            __builtin_amdgcn_global_load_lds((const unsigned*)(_bb + bo), (LAS unsigned*)(L + ((g) & 3) * 32768 + (16 * w + 4 * i) * 256), 16, 0, 0); } } while (0)
    v8i a[2][2], a2[2][2];
    { int ln = lane; asm volatile("" : "+v"(ln));
      E2_STAGE_B(0, cur.e); E2_STAGE_B(1, cur.e); E2_STAGE_B(2, cur.e); }
    load_a(a, HIDq, T, cur, w, lane);
#pragma unroll
    for (int mt = 0; mt < 2; ++mt)
#pragma unroll
        for (int ks = 0; ks < 2; ++ks) a2[mt][ks] = a[mt][ks];
    asm volatile("s_waitcnt vmcnt(0)" ::: "memory");
#pragma unroll 1
    for (int g = 0; g < nh; ++g) {
        int ln = lane; asm volatile("" : "+v"(ln)); const int fr = ln & 15, fq = ln >> 4;
        const int hf = g & 7;
        if (g + 3 > nh) asm volatile("s_waitcnt vmcnt(0)" ::: "memory"); else asm volatile("s_waitcnt vmcnt(20)" ::: "memory");
        WG_BARRIER();
        if (hf == 0 && g > 0) { cur = nxt; }
        if (hf == 4) { const int k1 = (g >> 3) + 1; if (k1 < ntl) tile_of(T, F.vcu + k1 * F.G, nxt); }
        if (g + 3 < nh) { const int te = ((g + 3) >> 3) == (g >> 3) ? cur.e : nxt.e; E2_STAGE_B(g + 3, te); }
        else {
            E2_STAGE_B(g + 3, cur.e); }
        if (hf == 5 && (g >> 3) + 1 < ntl) load_a(a2, HIDq, T, nxt, w, ln);
        f32x4 acc[2][8];
#pragma unroll
        for (int mt = 0; mt < 2; ++mt)
#pragma unroll
            for (int nt = 0; nt < 8; ++nt) acc[mt][nt] = (f32x4){0.f, 0.f, 0.f, 0.f};
        const LAS unsigned char* Bq = L + (g & 3) * 32768;
#pragma unroll
        for (int ks = 0; ks < 2; ++ks)
#pragma unroll
            for (int nt = 0; nt < 8; ++nt) {
                v8i b; b.lo = *(const LAS v4i*)(Bq + sw(16 * nt + fr, 8 * ks + fq)); b.hi = *(const LAS v4i*)(Bq + sw(16 * nt + fr, 8 * ks + 4 + fq));
                acc[0][nt] = __builtin_amdgcn_mfma_scale_f32_16x16x128_f8f6f4(b, a[0][ks], acc[0][nt], 0, 0, 0, 127, 0, 127);
                acc[1][nt] = __builtin_amdgcn_mfma_scale_f32_16x16x128_f8f6f4(b, a[1][ks], acc[1][nt], 0, 0, 0, 127, 0, 127);
            }
        constexpr float dq = YSCALE / (HQ_SCALE * WDQ_SCALE);
#pragma unroll
        for (int mt = 0; mt < 2; ++mt) {
            const int r = 32 * w + 16 * mt + fr;
            unsigned char* p = (r < cur.rows) ? YR + (size_t)(T.rowbase[cur.e] + cur.pm + r) * D + 128 * hf + 32 * fq : dump + (size_t)F.tid * 32;
#pragma unroll
            for (int q = 0; q < 2; ++q) { unsigned wd[4];
#pragma unroll
                for (int x = 0; x < 4; ++x) { const f32x4 v = acc[mt][4 * q + x] * dq; int t = __builtin_amdgcn_cvt_pk_fp8_f32(v[0], v[1], 0, false); t = __builtin_amdgcn_cvt_pk_fp8_f32(v[2], v[3], t, true); wd[x] = (unsigned)t; }
                *(v4u*)(p + 16 * q) = (v4u){wd[0], wd[1], wd[2], wd[3]}; }
        }
        if (hf == 7) {
#pragma unroll
            for (int mt = 0; mt < 2; ++mt)
#pragma unroll
                for (int ks = 0; ks < 2; ++ks) a[mt][ks] = a2[mt][ks];
        }
    }
#undef E2_STAGE_B
    asm volatile("s_waitcnt vmcnt(0)" ::: "memory");
    WG_BARRIER();
}
}

template <class P>
__device__ __forceinline__ void moe_fill_units(Frame& F, P& p, LAS int* ut) {
    const int nu = p.nunits(), slot = F.tid, i = F.vcu + slot * F.G;
    if (i < nu) { Unit u; p.unit(i, u); ut[4 * slot] = u.e; ut[4 * slot + 1] = u.pm; ut[4 * slot + 2] = u.rows; ut[4 * slot + 3] = u.pn; }
    __syncthreads();
    p.ut = ut;
}
__device__ __forceinline__ void e1_fill_idx(Frame& F, const ProbE1& p) {
    const int nu = p.nunits(), G = F.G;
    int tv[11];
#pragma unroll
    for (int slot = 0; slot < 11; ++slot) { const int i = F.vcu + slot * G; tv[slot] = 0;
        if (i < nu && F.tid < 256) { Unit u; p.unit(i, u, slot); tv[slot] = p.token(u, F.tid); } }
#pragma unroll
    for (int slot = 0; slot < 11; ++slot) { const int i = F.vcu + slot * G; if (i < nu && F.tid < 256) p.idx[slot * 256 + F.tid] = tv[slot]; }
    __syncthreads();
}

__device__ __forceinline__ void hgrn_naive(Frame& F) {
    const bf16* PROJ = (const bf16*)(F.ws + WS_PROJ); const float* LB = (const float*)(F.ws + WS_LB); float* ORAW = (float*)(F.ws + WS_ORAW);
    LAS float* qs = (LAS float*)F.lds; LAS float* fs = qs + 2 * 512; LAS float* ks = fs + 2 * 512;
    const int tid = F.tid, h = tid >> 7;
    for (int b = F.vcu; b < NB; b += F.G) {
        float S[128];
#pragma unroll
        for (int d = 0; d < 128; ++d) S[d] = 0.f;
        const float lb = LB[tid];
        for (int t = 0; t < NMETA + SEQ; ++t) {
            const size_t row = (t < NMETA) ? (size_t)(NTOK + t) : (size_t)b * SEQ + (t - NMETA);
            const bf16* pr = PROJ + row * PW;
            const int buf = (t & 1) * 512;
            const float q = bf2f(pr[tid]), z = bf2f(pr[512 + tid]), iv = bf2f(pr[1024 + tid]);
            const float f = lb + (1.f - lb) * sigmoidf_(z);
            qs[buf + tid] = q; fs[buf + tid] = f; ks[buf + tid] = (1.f - lb) * sigmoidf_(-z);
            __syncthreads();
            float o = 0.f;
            const LAS f32x4* q4 = (const LAS f32x4*)(qs + buf + h * 128); const LAS f32x4* f4 = (const LAS f32x4*)(fs + buf + h * 128); const LAS f32x4* k4 = (const LAS f32x4*)(ks + buf + h * 128);
#pragma unroll
            for (int d4 = 0; d4 < 32; ++d4) {
                const f32x4 qq = q4[d4], ff = f4[d4], kk = k4[d4];
#pragma unroll
                for (int j = 0; j < 4; ++j) { S[4 * d4 + j] = ff[j] * S[4 * d4 + j] + kk[j] * iv; o += qq[j] * S[4 * d4 + j]; }
            }
            if (t >= NMETA) ORAW[row * HW + tid] = o;
        }
        __syncthreads();
    }
}

namespace hg {
constexpr int BF_OFF = 0, TOT_OFF = 32768, BMID_OFF = 34816, BLAST_OFF = 35328, QT_OFF = 36864, KT_OFF = 53248, QH_OFF = 69632, VT_OFF = 86016, PP_OFF = 102400, OI_OFF = QT_OFF, CONST_OFF = 110592;
typedef short v4i16_t __attribute__((ext_vector_type(4)));
__device__ __forceinline__ int offb(int row, int ch) { return 256 * row + 16 * (ch ^ (((row & 3) << 2) | ((row >> 2) & 3))); }
__device__ __forceinline__ int off8(int row, int chunk) { return row * 128 + ((chunk ^ (row & 7)) << 4); }
__device__ __forceinline__ void unpack8(const v4u& w, float (&f)[8]) { f[0] = bflo(w.x); f[1] = bfhi(w.x); f[2] = bflo(w.y); f[3] = bfhi(w.y); f[4] = bflo(w.z); f[5] = bfhi(w.z); f[6] = bflo(w.w); f[7] = bfhi(w.w); }
__device__ __forceinline__ bf16x8 rowfrag(const LAS unsigned char* img, int lane, int rb, int s) { return *(const LAS bf16x8*)(img + offb((lane & 15) + 16 * rb, 4 * s + (lane >> 4))); }
__device__ __forceinline__ bf16x8 trfrag(const LAS unsigned char* img, int lane, int c, int ks) {
    const int g = lane >> 4, q = (lane & 15) >> 2, p = lane & 3;
    const v4i16_t lo = __builtin_amdgcn_ds_read_tr16_b64_v4i16((LAS v4i16_t*)(img + offb(32 * ks + 8 * g + q, 2 * c + (p >> 1)) + 8 * (p & 1)));
    const v4i16_t hi = __builtin_amdgcn_ds_read_tr16_b64_v4i16((LAS v4i16_t*)(img + offb(32 * ks + 8 * g + 4 + q, 2 * c + (p >> 1)) + 8 * (p & 1)));
    return (bf16x8){lo[0], lo[1], lo[2], lo[3], hi[0], hi[1], hi[2], hi[3]};
}
struct Chunks { v4u z[2], q[2], v[2]; };
template <bool WANT_Q, bool WANT_V = true, bool NT = false>
__device__ __forceinline__ void load_chunks(Chunks& c, const bf16* PROJ, size_t row0, int h, int nvalid, int tid) {
    const int cc = tid & 15; const char* base = (const char*)PROJ;
#pragma unroll
    for (int jj = 0; jj < 2; ++jj) {
        const int s = (tid >> 4) + 32 * jj; const unsigned o = (unsigned)(((unsigned)row0 + (unsigned)s) * (unsigned)PW + (unsigned)(h * 128 + 8 * cc)) * 2u;
        if (s < nvalid) { c.z[jj] = NT ? __builtin_nontemporal_load((const v4u*)(base + o + 1024)) : *(const v4u*)(base + o + 1024); if (WANT_V) c.v[jj] = *(const v4u*)(base + o + 2048);
            if (WANT_Q) c.q[jj] = NT ? __builtin_nontemporal_load((const v4u*)(base + o)) : *(const v4u*)(base + o); else c.q[jj] = (v4u){0u, 0u, 0u, 0u}; }
        else { c.z[jj] = (v4u){0u, 0u, 0u, 0u}; if (WANT_V) c.v[jj] = (v4u){0u, 0u, 0u, 0u}; c.q[jj] = (v4u){0u, 0u, 0u, 0u}; }
    }
}
template <bool WANT_Q>
__device__ __forceinline__ void prep(Frame& F, const Chunks& c, const float* LB, int h, int nvalid, int tid_ = -1) {
    LAS unsigned char* L = F.lds; const int tid = tid_ >= 0 ? tid_ : F.tid;
    LAS float* BF = (LAS float*)(L + BF_OFF); LAS float* TOT = (LAS float*)(L + TOT_OFF); LAS float* BMID = (LAS float*)(L + BMID_OFF); LAS float* BLAST = (LAS float*)(L + BLAST_OFF);
    const int cc = tid & 15;
    float lb[8]; { const f32x4 a = *(const f32x4*)(LB + h * 128 + 8 * cc), b = *(const f32x4*)(LB + h * 128 + 8 * cc + 4); lb[0] = a.x; lb[1] = a.y; lb[2] = a.z; lb[3] = a.w; lb[4] = b.x; lb[5] = b.y; lb[6] = b.z; lb[7] = b.w; }
    float kreg[2][8];
#pragma unroll
    for (int jj = 0; jj < 2; ++jj) {
        if (jj == 1) __builtin_amdgcn_sched_barrier(0);
        const int s = (tid >> 4) + 32 * jj; float z[8]; unpack8(c.z[jj], z); f32x4 o0, o1;
#pragma unroll
        for (int e = 0; e < 8; ++e) { const float f = lb[e] + (1.f - lb[e]) * sigmoidf_(z[e]); const float lf = (s < nvalid) ? flog_(f) : 0.f; kreg[jj][e] = (s < nvalid) ? 1.f - f : 0.f; if (e < 4) o0[e] = lf; else o1[e - 4] = lf; }
        *(LAS f32x4*)(BF + s * 128 + 8 * cc) = o0; *(LAS f32x4*)(BF + s * 128 + 8 * cc + 4) = o1;
    }
    WG_BARRIER();
    {
        const int d = tid & 127, seg = tid >> 7; float run = 0.f;
#pragma unroll
        for (int i = 0; i < 16; ++i) { run += BF[(16 * seg + i) * 128 + d]; BF[(16 * seg + i) * 128 + d] = run; }
        TOT[seg * 128 + d] = run;
    }
    WG_BARRIER();
    float o1[8], bm[8], o3[8];
    { float bl[8];
#pragma unroll
      for (int hq = 0; hq < 2; ++hq) { const f32x4 a0 = *(const LAS f32x4*)(TOT + 8 * cc + 4 * hq), a1 = *(const LAS f32x4*)(TOT + 128 + 8 * cc + 4 * hq), a2 = *(const LAS f32x4*)(TOT + 256 + 8 * cc + 4 * hq), a3 = *(const LAS f32x4*)(TOT + 384 + 8 * cc + 4 * hq);
#pragma unroll
          for (int e = 0; e < 4; ++e) { o1[4 * hq + e] = a0[e]; bm[4 * hq + e] = a0[e] + a1[e]; o3[4 * hq + e] = (a0[e] + a1[e]) + a2[e]; bl[4 * hq + e] = (a0[e] + a1[e]) + (a2[e] + a3[e]); } }
      if ((tid >> 4) == 0) {
          *(LAS f32x4*)(BMID + 8 * cc) = (f32x4){bm[0], bm[1], bm[2], bm[3]}; *(LAS f32x4*)(BMID + 8 * cc + 4) = (f32x4){bm[4], bm[5], bm[6], bm[7]};
          *(LAS f32x4*)(BLAST + 8 * cc) = (f32x4){bl[0], bl[1], bl[2], bl[3]}; *(LAS f32x4*)(BLAST + 8 * cc + 4) = (f32x4){bl[4], bl[5], bl[6], bl[7]}; } }
    const bool upper = (tid >> 8) != 0;
    float ebm[8];
    if (WANT_Q) {
#pragma unroll
        for (int e = 0; e < 8; ++e) ebm[e] = fexp_(bm[e]);
    }
#pragma unroll
    for (int jj = 0; jj < 2; ++jj) {
        const int s = (tid >> 4) + 32 * jj;
        float q[8], bb[8]; unpack8(c.q[jj], q);
        { const f32x4 a = *(const LAS f32x4*)(BF + s * 128 + 8 * cc), b = *(const LAS f32x4*)(BF + s * 128 + 8 * cc + 4); bb[0] = a.x; bb[1] = a.y; bb[2] = a.z; bb[3] = a.w; bb[4] = b.x; bb[5] = b.y; bb[6] = b.z; bb[7] = b.w; }
#pragma unroll
        for (int e = 0; e < 8; ++e) bb[e] += (jj == 0) ? (upper ? o1[e] : 0.f) : (upper ? o3[e] : bm[e]);
        float kt[8], qt[8], qh[8];
#pragma unroll
        for (int e = 0; e < 8; ++e) {
            const float E = fexp_(bm[e] - bb[e]);
            kt[e] = kreg[jj][e] * E;
            if (WANT_Q) { qt[e] = q[e] * rcpf_(E); qh[e] = qt[e] * ebm[e]; }
        }
        *(LAS v4u*)(L + KT_OFF + offb(s, cc)) = (v4u){pk2(kt[0], kt[1]), pk2(kt[2], kt[3]), pk2(kt[4], kt[5]), pk2(kt[6], kt[7])};
        if (WANT_Q) {
            *(LAS v4u*)(L + QT_OFF + offb(s, cc)) = (v4u){pk2(qt[0], qt[1]), pk2(qt[2], qt[3]), pk2(qt[4], qt[5]), pk2(qt[6], qt[7])};
            *(LAS v4u*)(L + QH_OFF + offb(s, cc)) = (v4u){pk2(qh[0], qh[1]), pk2(qh[2], qh[3]), pk2(qh[4], qh[5]), pk2(qh[6], qh[7])};
        }
        *(LAS v4u*)(L + VT_OFF + offb(s, cc)) = c.v[jj];
    }
    WG_BARRIER();
}

__device__ __forceinline__ void pa_item(int it, int& h, int& nvalid, size_t& row0) {
    if (it < 16 * 127) { const int bh = it / 127, c = it % 127; h = bh & 3; row0 = (size_t)(bh >> 2) * SEQ + 64 * c; nvalid = 64; }
    else { h = it - 16 * 127; row0 = NTOK; nvalid = NMETA; }
}
__device__ __forceinline__ void pass_a(Frame& F) {
    const bf16* PROJ = (const bf16*)(F.ws + WS_PROJ); const float* LB = (const float*)(F.ws + WS_LB);
    bf16* DS = (bf16*)(F.ws + WS_DS); bf16* DSM = (bf16*)(F.ws + WS_DSM); float* DD = (float*)(F.ws + WS_DD);
    LAS unsigned char* L = F.lds; const int lane = F.lane, fr = lane & 15, fq = lane >> 4, w = F.wave;
    constexpr int NITEMS = 16 * 127 + 4;
    if (F.vcu >= NITEMS) return;
    Chunks ch; { int h, nv; size_t r0; pa_item(F.vcu, h, nv, r0); load_chunks<false>(ch, PROJ, r0, h, nv, F.tid); }
    for (int it = F.vcu; it < NITEMS; it += F.G) {
        int h, nvalid; size_t row0; pa_item(it, h, nvalid, row0);
        bf16* dst; float* ddst = nullptr;
        if (it < 16 * 127) { const int bh = it / 127, c = it % 127; dst = DS + (size_t)(bh * 128 + c) * 16384; ddst = DD + (size_t)(bh * 128 + c) * 128; } else dst = DSM + (size_t)h * 16384;
        prep<false>(F, ch, LB, h, nvalid);
        if (it + F.G < NITEMS) { int h2, nv2; size_t r2; pa_item(it + F.G, h2, nv2, r2); load_chunks<false>(ch, PROJ, r2, h2, nv2, F.tid); }
        f32x4 acc[8];
#pragma unroll
        for (int n = 0; n < 8; ++n) acc[n] = (f32x4){0.f, 0.f, 0.f, 0.f};
#pragma unroll
        for (int kk = 0; kk < 2; ++kk) {
            const bf16x8 a = trfrag(L + KT_OFF, lane, w, kk);
#pragma unroll
            for (int n = 0; n < 8; ++n) { const bf16x8 b = trfrag(L + VT_OFF, lane, n, kk); acc[n] = __builtin_amdgcn_mfma_f32_16x16x32_bf16(a, b, acc[n], 0, 0, 0); }
        }
        const LAS float* BMID = (const LAS float*)(L + BMID_OFF); const LAS float* BLAST = (const LAS float*)(L + BLAST_OFF);
        float sc[4];
#pragma unroll
        for (int j = 0; j < 4; ++j) { const int d = 16 * w + 4 * fq + j; sc[j] = fexp_(BLAST[d] - BMID[d]); }
#pragma unroll
        for (int n = 0; n < 8; ++n) { const int v = 16 * n + fr; *(v2u*)(dst + (size_t)v * 128 + 16 * w + 4 * fq) = (v2u){pk2(acc[n][0] * sc[0], acc[n][1] * sc[1]), pk2(acc[n][2] * sc[2], acc[n][3] * sc[3])}; }
        if (ddst && F.tid < 128) ddst[F.tid] = fexp_(BLAST[F.tid]);
        WG_BARRIER();
    }
}
__device__ __forceinline__ void scan_phase(Frame& F) {
    const bf16* DS = (const bf16*)(F.ws + WS_DS); const bf16* DSM = (const bf16*)(F.ws + WS_DSM); const float* DD = (const float*)(F.ws + WS_DD); bf16* SS = (bf16*)(F.ws + WS_SS);
    for (int t = F.vcu * NTHREADS + F.tid; t < 16 * 8192; t += F.G * NTHREADS) {
        const int bh = t >> 13, rem = t & 8191, v = rem >> 6, d = 2 * (rem & 63), h = bh & 3;
        const unsigned m = *(const unsigned*)(DSM + (size_t)h * 16384 + v * 128 + d);
        float s0 = bflo(m), s1 = bfhi(m);
        const size_t base = (size_t)bh * 128 * 16384 + (size_t)v * 128 + d;
        *(unsigned*)(SS + base) = m;
        const bf16* dsp = DS + base; const float* ddp = DD + (size_t)bh * 128 * 128 + d; bf16* ssp = SS + base + 16384;
        for (int c0 = 0; c0 < 127; c0 += 16) {
            unsigned ds[16]; f32x2 dd[16];
#pragma unroll
            for (int i = 0; i < 16; ++i) { const int c = (c0 + i < 127) ? c0 + i : 126; ds[i] = *(const unsigned*)(dsp + (size_t)c * 16384); dd[i] = *(const f32x2*)(ddp + (size_t)c * 128); }
#pragma unroll
            for (int i = 0; i < 16; ++i) if (c0 + i < 127) { s0 = dd[i].x * s0 + bflo(ds[i]); s1 = dd[i].y * s1 + bfhi(ds[i]); *(unsigned*)(ssp + (size_t)(c0 + i) * 16384) = pk2(s0, s1); }
        }
    }
}
__device__ __forceinline__ void pass_c(Frame& F) {
    const bf16* PROJ = (const bf16*)(F.ws + WS_PROJ); const float* LB = (const float*)(F.ws + WS_LB); const bf16* SS = (const bf16*)(F.ws + WS_SS); bf16* Y = (bf16*)(F.ws + WS_Y);
    const float* hg_ = F.in[5]; const float* cw = F.in[6]; const float* cg = F.in[7];
    LAS unsigned char* L = F.lds; const int tid = F.tid, lane = F.lane, fr = lane & 15, fq = lane >> 4, w = F.wave, cc = tid & 15;
    constexpr int NITEMS = 16 * 128;
    if (F.vcu >= NITEMS) return;
    Chunks ch; v4u st[4];
    { const int it = F.vcu, bh = it >> 7, c = it & 127; load_chunks<true>(ch, PROJ, (size_t)(bh >> 2) * SEQ + 64 * c, bh & 3, 64, tid);
      const bf16* sp = SS + (size_t)it * 16384;
#pragma unroll
      for (int i = 0; i < 4; ++i) st[i] = *(const v4u*)(sp + (size_t)(tid + 512 * i) * 8); }
    for (int it = F.vcu; it < NITEMS; it += F.G) {
        const int bh = it >> 7, c = it & 127, b = bh >> 2, h = bh & 3; const size_t row0 = (size_t)b * SEQ + 64 * c;
        prep<true>(F, ch, LB, h, 64);
#pragma unroll
        for (int i = 0; i < 4; ++i) { const int ci = tid + 512 * i; *(LAS v4u*)(L + BF_OFF + offb(ci >> 4, ci & 15)) = st[i]; }
        if (it + F.G < NITEMS) { const int it2 = it + F.G, bh2 = it2 >> 7, c2 = it2 & 127; load_chunks<true>(ch, PROJ, (size_t)(bh2 >> 2) * SEQ + 64 * c2, bh2 & 3, 64, tid);
            const bf16* sp = SS + (size_t)it2 * 16384;
#pragma unroll
            for (int i = 0; i < 4; ++i) st[i] = *(const v4u*)(sp + (size_t)(tid + 512 * i) * 8); }
        v4u eg[2], eb[2], ec0[2], ev0[2], ec1[2], ev1[2], ec2[2], ev2[2];
#pragma unroll
        for (int jj = 0; jj < 2; ++jj) {
            const int s = (tid >> 4) + 32 * jj, t = 64 * c + s; const bf16* pr = PROJ + (row0 + s) * PW + h * 128 + 8 * cc;
            const bf16* p1 = (t >= 1) ? pr - PW : PROJ + (size_t)(NTOK + 15) * PW + h * 128 + 8 * cc;
            const bf16* p2 = (t >= 2) ? pr - 2 * PW : PROJ + (size_t)(NTOK + 14 + t) * PW + h * 128 + 8 * cc;
            eg[jj] = *(const v4u*)(pr + 1536); eb[jj] = *(const v4u*)(pr + 2048); ec0[jj] = *(const v4u*)(pr + 2560); ev0[jj] = *(const v4u*)(pr + 3072);
            ec1[jj] = *(const v4u*)(p1 + 2560); ev1[jj] = *(const v4u*)(p1 + 3072); ec2[jj] = *(const v4u*)(p2 + 2560); ev2[jj] = *(const v4u*)(p2 + 3072);
        }
        {
            const int ti = w & 3; f32x4 sa[2] = {(f32x4){0.f, 0.f, 0.f, 0.f}, (f32x4){0.f, 0.f, 0.f, 0.f}};
#pragma unroll
            for (int kk = 0; kk < 4; ++kk) {
                const bf16x8 a = rowfrag(L + QT_OFF, lane, ti, kk);
#pragma unroll
                for (int x = 0; x < 2; ++x) { const bf16x8 bb = rowfrag(L + KT_OFF, lane, 2 * (w >> 2) + x, kk); sa[x] = __builtin_amdgcn_mfma_f32_16x16x32_bf16(a, bb, sa[x], 0, 0, 0); }
            }
#pragma unroll
            for (int x = 0; x < 2; ++x) { const int s = 16 * (2 * (w >> 2) + x) + fr;
#pragma unroll
                for (int j = 0; j < 4; ++j) { const int t = 16 * ti + 4 * fq + j; const float pv = (t >= s) ? sa[x][j] : 0.f; *(LAS bf16*)(L + PP_OFF + off8(t, s >> 3) + 2 * (s & 7)) = (bf16)f2bf(pv); } }
        }
        WG_BARRIER();
        {
            const int ti = w & 3; f32x4 oa[4];
#pragma unroll
            for (int n = 0; n < 4; ++n) oa[n] = (f32x4){0.f, 0.f, 0.f, 0.f};
#pragma unroll
            for (int kk = 0; kk < 2; ++kk) {
                const bf16x8 a = *(const LAS bf16x8*)(L + PP_OFF + off8(16 * ti + fr, 4 * kk + fq));
#pragma unroll
                for (int n = 0; n < 4; ++n) { const bf16x8 bb = trfrag(L + VT_OFF, lane, 4 * (w >> 2) + n, kk); oa[n] = __builtin_amdgcn_mfma_f32_16x16x32_bf16(a, bb, oa[n], 0, 0, 0); }
            }
#pragma unroll
            for (int kk = 0; kk < 4; ++kk) {
                const bf16x8 a = rowfrag(L + QH_OFF, lane, ti, kk);
#pragma unroll
                for (int n = 0; n < 4; ++n) { const bf16x8 bb = rowfrag(L + BF_OFF, lane, 4 * (w >> 2) + n, kk); oa[n] = __builtin_amdgcn_mfma_f32_16x16x32_bf16(a, bb, oa[n], 0, 0, 0); }
            }
            LAS float* OI = (LAS float*)(L + OI_OFF);
#pragma unroll
            for (int n = 0; n < 4; ++n) { const int v = 16 * (4 * (w >> 2) + n) + fr;
#pragma unroll
                for (int j = 0; j < 4; ++j) { const int t = 16 * ti + 4 * fq + j; OI[t * 128 + (v ^ (((t >> 2) & 1) << 4))] = oa[n][j]; } }
        }
        WG_BARRIER();
        {
            const LAS float* OI = (const LAS float*)(L + OI_OFF);
            float hgn[8], cgn[8], w0[8], w1[8], w2[8];
            { const int c8 = h * 128 + 8 * cc;
              const f32x4 a = *(const f32x4*)(hg_ + c8), b2 = *(const f32x4*)(hg_ + c8 + 4), c4 = *(const f32x4*)(cg + c8), d4 = *(const f32x4*)(cg + c8 + 4);
              const f32x4 k0a = *(const f32x4*)(cw + c8), k0b = *(const f32x4*)(cw + c8 + 4), k1a = *(const f32x4*)(cw + HW + c8), k1b = *(const f32x4*)(cw + HW + c8 + 4), k2a = *(const f32x4*)(cw + 2 * HW + c8), k2b = *(const f32x4*)(cw + 2 * HW + c8 + 4);
#pragma unroll
              for (int e = 0; e < 4; ++e) { hgn[e] = a[e]; hgn[4 + e] = b2[e]; cgn[e] = c4[e]; cgn[4 + e] = d4[e]; w0[e] = k0a[e]; w0[4 + e] = k0b[e]; w1[e] = k1a[e]; w1[4 + e] = k1b[e]; w2[e] = k2a[e]; w2[4 + e] = k2b[e]; } }
#pragma unroll
            for (int jj = 0; jj < 2; ++jj) {
                const int s = (tid >> 4) + 32 * jj; const size_t row = row0 + s;
                const int vo = (8 * cc) ^ (((s >> 2) & 1) << 4);
                const f32x4 oa4 = *(const LAS f32x4*)(OI + s * 128 + vo), ob4 = *(const LAS f32x4*)(OI + s * 128 + vo + 4);
                float o[8] = {oa4[0], oa4[1], oa4[2], oa4[3], ob4[0], ob4[1], ob4[2], ob4[3]};
                float ss = 0.f;
#pragma unroll
                for (int e = 0; e < 8; ++e) ss += o[e] * o[e];
                ss += __shfl_xor(ss, 1); ss += __shfl_xor(ss, 2); ss += __shfl_xor(ss, 4); ss += __shfl_xor(ss, 8);
                const float rs = rsqf_(ss * (1.f / 128.f) + EPS);
                float g[8]; unpack8(eg[jj], g);
                float yh[8];
#pragma unroll
                for (int e = 0; e < 8; ++e) yh[e] = o[e] * rs * hgn[e] * siluf_(g[e]);
                *(v4u*)(Y + row * D + h * 128 + 8 * cc) = (v4u){pk2(yh[0], yh[1]), pk2(yh[2], yh[3]), pk2(yh[4], yh[5]), pk2(yh[6], yh[7])};
                float bg[8], c0f[8], v0f[8], c1f[8], v1f[8], c2f[8], v2f[8];
                unpack8(eb[jj], bg); unpack8(ec0[jj], c0f); unpack8(ev0[jj], v0f); unpack8(ec1[jj], c1f); unpack8(ev1[jj], v1f); unpack8(ec2[jj], c2f); unpack8(ev2[jj], v2f);
                float yc[8]; float s2 = 0.f;
#pragma unroll
                for (int e = 0; e < 8; ++e) { const float cv = w0[e] * (c2f[e] * v2f[e]) + w1[e] * (c1f[e] * v1f[e]) + w2[e] * (c0f[e] * v0f[e]); yc[e] = bg[e] * cv; s2 += yc[e] * yc[e]; }
                s2 += __shfl_xor(s2, 1); s2 += __shfl_xor(s2, 2); s2 += __shfl_xor(s2, 4); s2 += __shfl_xor(s2, 8);
                const float rc = rsqf_(s2 * (1.f / 128.f) + EPS);
#pragma unroll
                for (int e = 0; e < 8; ++e) yc[e] = yc[e] * rc * cgn[e];
                *(v4u*)(Y + row * D + HW + h * 128 + 8 * cc) = (v4u){pk2(yc[0], yc[1]), pk2(yc[2], yc[3]), pk2(yc[4], yc[5]), pk2(yc[6], yc[7])};
            }
        }
    }
    WG_BARRIER();
}
constexpr int SEG_CH = 8, NSEG = 16;
__device__ __forceinline__ void seg_step(int bh, int seg, int k, int& h, int& nvalid, size_t& row0, int& chunk) {
    h = bh & 3;
    if (seg == 0) { if (k == 0) { row0 = NTOK; nvalid = NMETA; chunk = -1; return; } chunk = k - 1; }
    else chunk = seg * SEG_CH + k;
    row0 = (size_t)(bh >> 2) * SEQ + 64 * chunk; nvalid = 64;
}
template <bool LOGD>
__device__ __forceinline__ void state_step(LAS unsigned char* L, int lane, int w, f32x4 (&S)[8], float (&logd)[4]) {
    const int fq = lane >> 4;
    const LAS float* BMID = (const LAS float*)(L + BMID_OFF); const LAS float* BLAST = (const LAS float*)(L + BLAST_OFF);
    float sc[4], dc[4];
#pragma unroll
    for (int j = 0; j < 4; ++j) { const int d = 16 * w + 4 * fq + j; const float bl = BLAST[d]; sc[j] = fexp_(bl - BMID[d]); dc[j] = fexp_(bl); if (LOGD) logd[j] += bl; }
    const bf16x8 a0 = trfrag(L + KT_OFF, lane, w, 0), a1 = trfrag(L + KT_OFF, lane, w, 1);
#pragma unroll
    for (int hf = 0; hf < 2; ++hf) {
        f32x4 acc[4];
#pragma unroll
        for (int n = 0; n < 4; ++n) { acc[n] = (f32x4){0.f, 0.f, 0.f, 0.f};
            acc[n] = __builtin_amdgcn_mfma_f32_16x16x32_bf16(a0, trfrag(L + VT_OFF, lane, 4 * hf + n, 0), acc[n], 0, 0, 0);
            acc[n] = __builtin_amdgcn_mfma_f32_16x16x32_bf16(a1, trfrag(L + VT_OFF, lane, 4 * hf + n, 1), acc[n], 0, 0, 0); }
#pragma unroll
        for (int n = 0; n < 4; ++n)
#pragma unroll
            for (int j = 0; j < 4; ++j) S[4 * hf + n][j] = S[4 * hf + n][j] * dc[j] + acc[n][j] * sc[j];
    }
}
__device__ __forceinline__ void pass_a2(Frame& F) {
    const bf16* PROJ = (const bf16*)(F.ws + WS_PROJ); const float* LB = (const float*)(F.ws + WS_LB);
    float* DSEG = (float*)(F.ws + WS_SS); float* DDSEG = (float*)(F.ws + WS_DD);
    LAS unsigned char* L = F.lds; const int lane = F.lane, fr = lane & 15, fq = lane >> 4, w = F.wave;
    for (int it = F.vcu; it < 16 * NSEG; it += F.G) {
        const int bh = it >> 4, seg = it & 15, nsteps = SEG_CH + (seg == 0 ? 1 : 0);
        f32x4 S[8]; float logd[4] = {0.f, 0.f, 0.f, 0.f};
#pragma unroll
        for (int n = 0; n < 8; ++n) S[n] = (f32x4){0.f, 0.f, 0.f, 0.f};
        Chunks ch; { int h, nv, c; size_t r0; seg_step(bh, seg, 0, h, nv, r0, c); load_chunks<false>(ch, PROJ, r0, h, nv, F.tid); }
        for (int k = 0; k < nsteps; ++k) {
            int h, nvalid, c; size_t row0; seg_step(bh, seg, k, h, nvalid, row0, c);
            prep<false>(F, ch, LB, h, nvalid);
            if (k + 1 < nsteps) { int h2, nv2, c2; size_t r2; seg_step(bh, seg, k + 1, h2, nv2, r2, c2); load_chunks<false>(ch, PROJ, r2, h2, nv2, F.tid); }
            state_step<true>(L, lane, w, S, logd);
            if (seg == 0 && k == 0 && bh < 4) {
                float* sm = (float*)(F.ws + WS_DSM) + (size_t)bh * 16384;
#pragma unroll
                for (int n = 0; n < 8; ++n) *(f32x4*)(sm + (size_t)(16 * n + fr) * 128 + 16 * w + 4 * fq) = S[n];
            }
            WG_BARRIER();
        }
        float* dst = DSEG + (size_t)it * 16384;
#pragma unroll
        for (int n = 0; n < 8; ++n) *(f32x4*)(dst + (size_t)(16 * n + fr) * 128 + 16 * w + 4 * fq) = S[n];
        if (fr == 0) *(f32x4*)(DDSEG + (size_t)it * 128 + 16 * w + 4 * fq) = (f32x4){fexp_(logd[0]), fexp_(logd[1]), fexp_(logd[2]), fexp_(logd[3])};
    }
}
__device__ __forceinline__ void scan_seg(Frame& F) {
    float* DSEG = (float*)(F.ws + WS_SS); const float* DDSEG = (const float*)(F.ws + WS_DD);
    if (F.tid >= 256) return;
    for (int gt = (int)blockIdx.x * 256 + F.tid; gt < 16 * 4096; gt += F.G * 256) {
        const int bh = gt >> 12, e4 = gt & 4095;
        float* base = DSEG + (size_t)bh * NSEG * 16384 + 4 * e4; const float* db = DDSEG + (size_t)bh * NSEG * 128 + ((4 * e4) & 127);
        f32x4 dv[NSEG - 1], dd[NSEG - 1];
#pragma unroll
        for (int g = 0; g < NSEG - 1; ++g) { dv[g] = *(const f32x4*)(base + (size_t)g * 16384); dd[g] = *(const f32x4*)(db + g * 128); }
        f32x4 S = dv[0];
#pragma unroll
        for (int g = 1; g < NSEG - 1; ++g) { S = S * dd[g] + dv[g]; *(f32x4*)(base + (size_t)g * 16384) = S; }
    }
}
__device__ __forceinline__ void pass_c2(Frame& F) {
    const bf16* PROJ = (const bf16*)(F.ws + WS_PROJ); const float* LB = (const float*)(F.ws + WS_LB); bf16* Y = (bf16*)(F.ws + WS_Y);
    const float* DSEG = (const float*)(F.ws + WS_SS); const float* DDSEG = (const float*)(F.ws + WS_DD);
    const float* hg_ = F.in[5]; const float* cw = F.in[6]; const float* cg = F.in[7];
    LAS unsigned char* L = F.lds; const int w = F.wave;
    for (int it = F.vcu; it < 16 * NSEG; it += F.G) {
        const int bh = it >> 4, seg = it & 15, b = bh >> 2, h = bh & 3, nsteps = SEG_CH;
        int tid0 = F.tid; asm volatile("" : "+v"(tid0)); int lane0 = tid0 & 63;
        if (tid0 < 128) { LAS float* CT = (LAS float*)(L + CONST_OFF); const int c8 = h * 128 + tid0; CT[tid0] = hg_[c8]; CT[128 + tid0] = cg[c8]; CT[256 + tid0] = cw[c8]; CT[384 + tid0] = cw[HW + c8]; CT[512 + tid0] = cw[2 * HW + c8]; }
        Chunks ch; { int h0, nv, c; size_t r0; seg_step(bh, seg, seg == 0 ? 1 : 0, h0, nv, r0, c); load_chunks<true, false, true>(ch, PROJ, r0, h0, nv, tid0); }
        f32x4 S[8]; float logd[4] = {0.f, 0.f, 0.f, 0.f};
#pragma unroll
        for (int n = 0; n < 8; ++n) S[n] = (f32x4){0.f, 0.f, 0.f, 0.f};
        { const int fr = lane0 & 15, fq = lane0 >> 4;
        if (seg == 0) { const float* sm = (const float*)(F.ws + WS_DSM) + (size_t)h * 16384;
#pragma unroll
            for (int n = 0; n < 8; ++n) S[n] = *(const f32x4*)(sm + (size_t)(16 * n + fr) * 128 + 16 * w + 4 * fq); }
        if (seg > 0) {
            const float* src = DSEG + (size_t)(bh * NSEG + seg - 1) * 16384;
#pragma unroll
            for (int n = 0; n < 8; ++n) S[n] = *(const f32x4*)(src + (size_t)(16 * n + fr) * 128 + 16 * w + 4 * fq);
        } }
        for (int k = 0; k < nsteps; ++k) {
            int hh, nvalid, c; size_t row0; seg_step(bh, seg, k + (seg == 0 ? 1 : 0), hh, nvalid, row0, c);
            int tl = tid0; asm volatile("" : "+v"(tl)); const int tid = tl, cc = tl & 15, ln = tl & 63, fr = ln & 15, fq = ln >> 4;
            if (c < 0) {
                prep<false>(F, ch, LB, h, nvalid, tid);
                { int h2, nv2, c2; size_t r2; seg_step(bh, seg, k + 1, h2, nv2, r2, c2); load_chunks<true, false, true>(ch, PROJ, r2, h2, nv2, tid); }
                state_step<false>(L, ln, w, S, logd);
                WG_BARRIER();
                continue;
            }
            { const char* base = (const char*)PROJ;
#pragma unroll
              for (int jj = 0; jj < 2; ++jj) { const int s = (tid >> 4) + 32 * jj; ch.v[jj] = __builtin_nontemporal_load((const v4u*)(base + (unsigned)(((unsigned)row0 + (unsigned)s) * (unsigned)PW + (unsigned)(h * 128 + 8 * cc)) * 2u + 2048)); } }
            prep<true>(F, ch, LB, h, 64, tid);
#pragma unroll
            for (int n = 0; n < 8; ++n) { const int v = 16 * n + fr, d = 16 * w + 4 * fq; *(LAS v2u*)(L + BF_OFF + offb(v, d >> 3) + 2 * (d & 7)) = (v2u){pk2(S[n][0], S[n][1]), pk2(S[n][2], S[n][3])}; }
            v4u eg[2], eb[2], ec0[2], ev0[2], ec1[2], ev1[2], ec2[2], ev2[2];
#define HG_EPI_LOAD(jj) do { const int s = (tid >> 4) + 32 * (jj), t = 64 * c + s; const char* pb = (const char*)PROJ; const unsigned col = (unsigned)(h * 128 + 8 * cc) * 2u; \
                const unsigned o0 = ((unsigned)row0 + (unsigned)s) * (unsigned)(PW * 2) + col; \
                const unsigned o1 = (t >= 1) ? o0 - (unsigned)(PW * 2) : (unsigned)(NTOK + 15) * (unsigned)(PW * 2) + col; \
                const unsigned o2 = (t >= 2) ? o0 - (unsigned)(PW * 4) : (unsigned)(NTOK + 14 + t) * (unsigned)(PW * 2) + col; \
                eg[jj] = __builtin_nontemporal_load((const v4u*)(pb + o0 + 3072)); eb[jj] = __builtin_nontemporal_load((const v4u*)(pb + o0 + 4096)); ec0[jj] = *(const v4u*)(pb + o0 + 5120); ev0[jj] = *(const v4u*)(pb + o0 + 6144); \
                ec1[jj] = *(const v4u*)(pb + o1 + 5120); ev1[jj] = *(const v4u*)(pb + o1 + 6144); ec2[jj] = *(const v4u*)(pb + o2 + 5120); ev2[jj] = *(const v4u*)(pb + o2 + 6144); } while (0)
            HG_EPI_LOAD(0);
            {
                const int ti = w & 3; f32x4 sa[2] = {(f32x4){0.f, 0.f, 0.f, 0.f}, (f32x4){0.f, 0.f, 0.f, 0.f}};
#pragma unroll
                for (int kk = 0; kk < 4; ++kk) {
                    const bf16x8 a = rowfrag(L + QT_OFF, ln, ti, kk);
#pragma unroll
                    for (int x = 0; x < 2; ++x) { const bf16x8 bb = rowfrag(L + KT_OFF, ln, 2 * (w >> 2) + x, kk); sa[x] = __builtin_amdgcn_mfma_f32_16x16x32_bf16(a, bb, sa[x], 0, 0, 0); }
                }
#pragma unroll
                for (int x = 0; x < 2; ++x) { const int s = 16 * (2 * (w >> 2) + x) + fr;
#pragma unroll
                    for (int j = 0; j < 4; ++j) { const int t = 16 * ti + 4 * fq + j; const float pv = (t >= s) ? sa[x][j] : 0.f; *(LAS bf16*)(L + PP_OFF + off8(t, s >> 3) + 2 * (s & 7)) = (bf16)f2bf(pv); } }
            }
            WG_BARRIER();
            state_step<false>(L, ln, w, S, logd);
            if (k + 1 < nsteps) { int h2, nv2, c2; size_t r2; seg_step(bh, seg, k + 1 + (seg == 0 ? 1 : 0), h2, nv2, r2, c2); load_chunks<true, false, true>(ch, PROJ, r2, h2, nv2, tid); }
            HG_EPI_LOAD(1);
            {
                const int ti = w & 3; f32x4 oa[4];
#pragma unroll
                for (int n = 0; n < 4; ++n) oa[n] = (f32x4){0.f, 0.f, 0.f, 0.f};
#pragma unroll
                for (int kk = 0; kk < 2; ++kk) {
                    const bf16x8 a = *(const LAS bf16x8*)(L + PP_OFF + off8(16 * ti + fr, 4 * kk + fq));
#pragma unroll
                    for (int n = 0; n < 4; ++n) { const bf16x8 bb = trfrag(L + VT_OFF, ln, 4 * (w >> 2) + n, kk); oa[n] = __builtin_amdgcn_mfma_f32_16x16x32_bf16(a, bb, oa[n], 0, 0, 0); }
                }
#pragma unroll
                for (int kk = 0; kk < 4; ++kk) {
                    const bf16x8 a = rowfrag(L + QH_OFF, ln, ti, kk);
#pragma unroll
                    for (int n = 0; n < 4; ++n) { const bf16x8 bb = rowfrag(L + BF_OFF, ln, 4 * (w >> 2) + n, kk); oa[n] = __builtin_amdgcn_mfma_f32_16x16x32_bf16(a, bb, oa[n], 0, 0, 0); }
                }
#pragma unroll
                for (int n = 0; n < 4; ++n) { const int v = 16 * (4 * (w >> 2) + n) + fr;
#pragma unroll
                    for (int j = 0; j < 4; ++j) { const int t = 16 * ti + 4 * fq + j; *(LAS bf16*)(L + QT_OFF + offb(t, v >> 3) + 2 * (v & 7)) = (bf16)f2bf(oa[n][j]); } }
            }
#undef HG_EPI_LOAD
            WG_BARRIER();
            {
                const LAS float* CT = (const LAS float*)(L + CONST_OFF);
#pragma unroll
                for (int jj = 0; jj < 2; ++jj) {
                    const int s = (tid >> 4) + 32 * jj; const unsigned yo = (((unsigned)row0 + (unsigned)s) * (unsigned)D + (unsigned)(h * 128 + 8 * cc)) * 2u;
                    const v4u ow = *(const LAS v4u*)(L + QT_OFF + offb(s, cc)); float o[8]; unpack8(ow, o);
                    float ss = 0.f;
#pragma unroll
                    for (int e = 0; e < 8; ++e) ss += o[e] * o[e];
                    ss += __shfl_xor(ss, 1); ss += __shfl_xor(ss, 2); ss += __shfl_xor(ss, 4); ss += __shfl_xor(ss, 8);
                    const float rs = rsqf_(ss * (1.f / 128.f) + EPS);
                    float g[8]; unpack8(eg[jj], g);
                    const f32x4 ha = *(const LAS f32x4*)(CT + 8 * cc), hb = *(const LAS f32x4*)(CT + 8 * cc + 4);
                    float yh[8];
#pragma unroll
                    for (int e = 0; e < 8; ++e) yh[e] = o[e] * rs * (e < 4 ? ha[e] : hb[e - 4]) * siluf_(g[e]);
                    if constexpr (ProbOutQ) {
#pragma unroll
                        for (int e = 0; e < 8; ++e) yh[e] = __builtin_amdgcn_fmed3f(yh[e], -F8MAX, F8MAX);
                        int w0 = __builtin_amdgcn_cvt_pk_fp8_f32(yh[0], yh[1], 0, false); w0 = __builtin_amdgcn_cvt_pk_fp8_f32(yh[2], yh[3], w0, true);
                        int w1 = __builtin_amdgcn_cvt_pk_fp8_f32(yh[4], yh[5], 0, false); w1 = __builtin_amdgcn_cvt_pk_fp8_f32(yh[6], yh[7], w1, true);
                        *(v2u*)((char*)Y + (yo >> 1)) = (v2u){(unsigned)w0, (unsigned)w1};
                    } else
                    *(v4u*)((char*)Y + yo) = (v4u){pk2(yh[0], yh[1]), pk2(yh[2], yh[3]), pk2(yh[4], yh[5]), pk2(yh[6], yh[7])};
                }
#pragma unroll
                for (int jj = 0; jj < 2; ++jj) {
                    const int s = (tid >> 4) + 32 * jj; const unsigned yo = (((unsigned)row0 + (unsigned)s) * (unsigned)D + (unsigned)(h * 128 + 8 * cc)) * 2u;
                    float cf[8], vf[8], cv[8];
                    unpack8(ec2[jj], cf); unpack8(ev2[jj], vf);
                    { const f32x4 wa = *(const LAS f32x4*)(CT + 256 + 8 * cc), wb = *(const LAS f32x4*)(CT + 256 + 8 * cc + 4);
#pragma unroll
                      for (int e = 0; e < 8; ++e) cv[e] = (e < 4 ? wa[e] : wb[e - 4]) * (cf[e] * vf[e]); }
                    unpack8(ec1[jj], cf); unpack8(ev1[jj], vf);
                    { const f32x4 wa = *(const LAS f32x4*)(CT + 384 + 8 * cc), wb = *(const LAS f32x4*)(CT + 384 + 8 * cc + 4);
#pragma unroll
                      for (int e = 0; e < 8; ++e) cv[e] += (e < 4 ? wa[e] : wb[e - 4]) * (cf[e] * vf[e]); }
                    unpack8(ec0[jj], cf); unpack8(ev0[jj], vf);
                    { const f32x4 wa = *(const LAS f32x4*)(CT + 512 + 8 * cc), wb = *(const LAS f32x4*)(CT + 512 + 8 * cc + 4);
#pragma unroll
                      for (int e = 0; e < 8; ++e) cv[e] += (e < 4 ? wa[e] : wb[e - 4]) * (cf[e] * vf[e]); }
                    unpack8(eb[jj], cf);
                    float s2 = 0.f;
#pragma unroll
                    for (int e = 0; e < 8; ++e) { cv[e] *= cf[e]; s2 += cv[e] * cv[e]; }
                    s2 += __shfl_xor(s2, 1); s2 += __shfl_xor(s2, 2); s2 += __shfl_xor(s2, 4); s2 += __shfl_xor(s2, 8);
                    const float rc = rsqf_(s2 * (1.f / 128.f) + EPS);
                    const f32x4 ga = *(const LAS f32x4*)(CT + 128 + 8 * cc), gb = *(const LAS f32x4*)(CT + 128 + 8 * cc + 4);
#pragma unroll
                    for (int e = 0; e < 8; ++e) cv[e] = cv[e] * rc * (e < 4 ? ga[e] : gb[e - 4]);
                    if constexpr (ProbOutQ) {
                        int w0 = __builtin_amdgcn_cvt_pk_fp8_f32(cv[0], cv[1], 0, false); w0 = __builtin_amdgcn_cvt_pk_fp8_f32(cv[2], cv[3], w0, true);
                        int w1 = __builtin_amdgcn_cvt_pk_fp8_f32(cv[4], cv[5], 0, false); w1 = __builtin_amdgcn_cvt_pk_fp8_f32(cv[6], cv[7], w1, true);
                        *(v2u*)((char*)Y + (yo >> 1) + 512) = (v2u){(unsigned)w0, (unsigned)w1};
                    } else
                    *(v4u*)((char*)Y + yo + 1024) = (v4u){pk2(cv[0], cv[1]), pk2(cv[2], cv[3]), pk2(cv[4], cv[5]), pk2(cv[6], cv[7])};
                }
            }
        }
        WG_BARRIER();
    }
}
}

__device__ __forceinline__ void post_phase(Frame& F) {
    const bf16* PROJ = (const bf16*)(F.ws + WS_PROJ); const float* ORAW = (const float*)(F.ws + WS_ORAW); bf16* Y = (bf16*)(F.ws + WS_Y);
    const float* hg = F.in[5]; const float* cw = F.in[6]; const float* cg = F.in[7];
    const int gw = F.vcu * NWAVES + F.wave, NGW = F.G * NWAVES, lane = F.lane, c0 = 8 * lane;
    for (int row = gw; row < NTOK; row += NGW) {
        const int t = row & (SEQ - 1);
        const bf16* pr = PROJ + (size_t)row * PW;
        float o[8]; { const f32x4 a = *(const f32x4*)(ORAW + (size_t)row * HW + c0), b2 = *(const f32x4*)(ORAW + (size_t)row * HW + c0 + 4);
            o[0] = a.x; o[1] = a.y; o[2] = a.z; o[3] = a.w; o[4] = b2.x; o[5] = b2.y; o[6] = b2.z; o[7] = b2.w; }
        float ss = 0.f;
#pragma unroll
        for (int j = 0; j < 8; ++j) ss += o[j] * o[j];
        ss += __shfl_xor(ss, 1); ss += __shfl_xor(ss, 2); ss += __shfl_xor(ss, 4); ss += __shfl_xor(ss, 8);
        const float rs = rsqf_(ss * (1.f / 128.f) + EPS);
        const v4u gq = *(const v4u*)(pr + 1536 + c0);
        float gv[8] = {bflo(gq.x), bfhi(gq.x), bflo(gq.y), bfhi(gq.y), bflo(gq.z), bfhi(gq.z), bflo(gq.w), bfhi(gq.w)};
        float yh[8];
#pragma unroll
        for (int j = 0; j < 8; ++j) yh[j] = o[j] * rs * hg[c0 + j] * siluf_(gv[j]);
        v4u oh; oh.x = pk2(yh[0], yh[1]); oh.y = pk2(yh[2], yh[3]); oh.z = pk2(yh[4], yh[5]); oh.w = pk2(yh[6], yh[7]);
        *(v4u*)(Y + (size_t)row * D + c0) = oh;
        const bf16* p1 = (t >= 1) ? pr - PW : PROJ + (size_t)(NTOK + 15) * PW;
        const bf16* p2 = (t >= 2) ? pr - 2 * PW : PROJ + (size_t)(NTOK + 14 + t) * PW;
        float u0[8], u1[8], u2[8], bg[8];
        { const v4u c = *(const v4u*)(pr + 2560 + c0), v = *(const v4u*)(pr + 3072 + c0), bq = *(const v4u*)(pr + 2048 + c0);
          const unsigned cc[4] = {c.x, c.y, c.z, c.w}, vv[4] = {v.x, v.y, v.z, v.w}, bb[4] = {bq.x, bq.y, bq.z, bq.w};
#pragma unroll
          for (int j = 0; j < 4; ++j) { u0[2 * j] = bflo(cc[j]) * bflo(vv[j]); u0[2 * j + 1] = bfhi(cc[j]) * bfhi(vv[j]); bg[2 * j] = bflo(bb[j]); bg[2 * j + 1] = bfhi(bb[j]); } }
        { const v4u c = *(const v4u*)(p1 + 2560 + c0), v = *(const v4u*)(p1 + 3072 + c0); const unsigned cc[4] = {c.x, c.y, c.z, c.w}, vv[4] = {v.x, v.y, v.z, v.w};
#pragma unroll
          for (int j = 0; j < 4; ++j) { u1[2 * j] = bflo(cc[j]) * bflo(vv[j]); u1[2 * j + 1] = bfhi(cc[j]) * bfhi(vv[j]); } }
        { const v4u c = *(const v4u*)(p2 + 2560 + c0), v = *(const v4u*)(p2 + 3072 + c0); const unsigned cc[4] = {c.x, c.y, c.z, c.w}, vv[4] = {v.x, v.y, v.z, v.w};
#pragma unroll
          for (int j = 0; j < 4; ++j) { u2[2 * j] = bflo(cc[j]) * bflo(vv[j]); u2[2 * j + 1] = bfhi(cc[j]) * bfhi(vv[j]); } }
        float yc[8]; float s2 = 0.f;
#pragma unroll
        for (int j = 0; j < 8; ++j) { const float cv = cw[c0 + j] * u2[j] + cw[HW + c0 + j] * u1[j] + cw[2 * HW + c0 + j] * u0[j]; yc[j] = bg[j] * cv; s2 += yc[j] * yc[j]; }
        s2 += __shfl_xor(s2, 1); s2 += __shfl_xor(s2, 2); s2 += __shfl_xor(s2, 4); s2 += __shfl_xor(s2, 8);
        const float rc = rsqf_(s2 * (1.f / 128.f) + EPS);
#pragma unroll
        for (int j = 0; j < 8; ++j) yc[j] = yc[j] * rc * cg[c0 + j];
        v4u oc; oc.x = pk2(yc[0], yc[1]); oc.y = pk2(yc[2], yc[3]); oc.z = pk2(yc[4], yc[5]); oc.w = pk2(yc[6], yc[7]);
        *(v4u*)(Y + (size_t)row * D + HW + c0) = oc;
    }
}

__device__ __forceinline__ void router_phase(Frame& F) {
    const bf16* H1 = (const bf16*)(F.ws + WS_H1); const bf16* WrT = (const bf16*)(F.ws + WS_WR); const float* sumsq = (const float*)(F.ws + WS_SUMSQ);
    int* tokl = (int*)(F.ws + WS_TOK); f32x2* scl = (f32x2*)(F.ws + WS_SCL); f32x2* scls = (f32x2*)(F.ws + WS_SCLS); int* slot = (int*)(F.ws + WS_SLOT);
    unsigned* counts = (unsigned*)(F.ws + WS_CTL) + CW_CNT; const float* rbias = F.in[11];
    const int lane = F.lane, fr = lane & 15, fq = lane >> 4, w = F.wave, tid = F.tid;
    LAS float* sc = (LAS float*)F.lds + w * 2048;
    LAS float* kb = sc + 1024;
    LAS int* hist = (LAS int*)(F.lds + 65536);
    LAS int* base = hist + 64;
    LAS int* sel_e = base + 64;
    LAS int* sel_r = sel_e + 1024;
    LAS float* sel_g = (LAS float*)(sel_r + 1024);
    LAS float* sel_rs = sel_g + 1024;
    float bias4[4];
#pragma unroll
    for (int n = 0; n < 4; ++n) bias4[n] = rbias[16 * n + fr];
    for (int blk = F.vcu; blk < NTOK / 128; blk += F.G) {
        const int tok0 = blk * 128 + w * 16;
        f32x4 acc[4];
#pragma unroll
        for (int n = 0; n < 4; ++n) acc[n] = (f32x4){0.f, 0.f, 0.f, 0.f};
        const char* ap = (const char*)(H1 + (size_t)(tok0 + fr) * D + 8 * fq);
        bf16x8 af[4][8];
#pragma unroll
        for (int q = 0; q < 4; ++q) {
#pragma unroll
            for (int i = 0; i < 4; ++i) { const int pp = (w * 4 + i) * 64 + lane, row = pp >> 5, lc = (pp & 31) ^ (row & 15);
                __builtin_amdgcn_global_load_lds((const unsigned*)((const char*)WrT + (size_t)row * (D * 2) + q * 512 + lc * 16), (LAS unsigned*)(F.lds + q * 32768 + (w * 4 + i) * 1024), 16, 0, 0); }
#pragma unroll
            for (int ks = 0; ks < 8; ++ks) af[q][ks] = *(const bf16x8*)(ap + q * 512 + ks * 64);
        }
        const f32x4 ssq = *(const f32x4*)(sumsq + tok0 + 4 * fq);
        asm volatile("s_waitcnt vmcnt(0)" ::: "memory");
        WG_BARRIER();
#pragma unroll
        for (int q = 0; q < 4; ++q) {
            const LAS unsigned char* Bq = F.lds + q * 32768;
#pragma unroll
            for (int ks = 0; ks < 8; ++ks)
#pragma unroll
                for (int n = 0; n < 4; ++n) { const int row = 16 * n + fr; const bf16x8 b = *(const LAS bf16x8*)(Bq + row * 512 + (((4 * ks + fq) ^ (row & 15)) << 4));
                    acc[n] = __builtin_amdgcn_mfma_f32_16x16x32_bf16(af[q][ks], b, acc[n], 0, 0, 0); }
        }
        WG_BARRIER();
        if (tid < 64) hist[tid] = 0;
#pragma unroll
        for (int j = 0; j < 4; ++j) { const int r = 4 * fq + j; const float rs = rsqf_(ssq[j] * (1.f / D) + EPS);
#pragma unroll
            for (int n = 0; n < 4; ++n) { const int e = 16 * n + fr; const float s = sigmoidf_(acc[n][j] * rs); sc[r * 64 + e] = s;
                kb[r * 64 + e] = __builtin_bit_cast(float, (__builtin_bit_cast(unsigned, s + bias4[n]) & ~63u) | (unsigned)(63 - e)); }
            if (fr == 0) { sel_rs[w * 16 + r] = rs; scls[tok0 + r] = (f32x2){rs, rs}; } }
        __syncthreads();
#pragma unroll 2
        for (int r = 0; r < 16; ++r) {
            const float my = kb[r * 64 + lane]; int rank = 0;
#pragma unroll
            for (int e4 = 0; e4 < 16; ++e4) { const f32x4 o = *(const LAS f32x4*)(kb + r * 64 + 4 * e4); rank += (o[0] > my) + (o[1] > my) + (o[2] > my) + (o[3] > my); }
            if (rank < TOPK) { const int tl = w * 16 + r; sel_e[tl * 8 + rank] = lane; sel_g[tl * 8 + rank] = sc[r * 64 + lane];
                sel_r[tl * 8 + rank] = __hip_atomic_fetch_add(hist + lane, 1, __ATOMIC_RELAXED, __HIP_MEMORY_SCOPE_WORKGROUP); }
        }
        __syncthreads();
        if (tid < 64) base[tid] = (int)atomicAdd(counts + tid, (unsigned)hist[tid]);
        __syncthreads();
        for (int i = tid; i < 1024; i += NTHREADS) {
            const int e = sel_e[i], pos = base[e] + sel_r[i], token = blk * 128 + (i >> 3);
            const LAS f32x4* g4 = (const LAS f32x4*)(sel_g + (i & ~7)); const f32x4 ga = g4[0], gb = g4[1];
            const float ssum = ((ga[0] + ga[1]) + (ga[2] + ga[3])) + ((gb[0] + gb[1]) + (gb[2] + gb[3]));
            const float rs = sel_rs[i >> 3]; tokl[(size_t)e * NTOK + pos] = token; scl[(size_t)e * NTOK + pos] = (f32x2){rs, rs * sel_g[i] * (ROUTED_SCALE / ssum)}; slot[(size_t)token * 8 + (i & 7)] = (e << 16) | pos;
        }
        __syncthreads();
    }
}

struct CRows { v2u h[4]; unsigned ys[4]; unsigned y[8][4]; };
__device__ __forceinline__ void comb_issue(CRows& r, int tok, int sl, const bf16* H1, const unsigned char* YR, const unsigned char* YS, const MoeTab& T, int c0) {
    asm volatile("" : "+v"(c0));
    const unsigned ho = (unsigned)tok * (D * 2) + 2 * c0, so = (unsigned)tok * D + c0;
#pragma unroll
    for (int j = 0; j < 4; ++j) { r.h[j] = __builtin_nontemporal_load((const v2u*)((const char*)H1 + ho + 512 * j)); r.ys[j] = __builtin_nontemporal_load((const unsigned*)(YS + so + 256 * j)); }
#pragma unroll
    for (int k = 0; k < TOPK; ++k) { const int s = __shfl(sl, k); const int e = s >> 16, pos = s & 0xffff; const unsigned yo = (unsigned)(T.rowbase[e] + pos) * D + c0;
#pragma unroll
        for (int j = 0; j < 4; ++j) r.y[k][j] = __builtin_nontemporal_load((const unsigned*)(YR + yo + 256 * j)); }
}
__device__ __forceinline__ void comb_finish(const CRows& r, int tok, float* out, const f32x4 (&gv)[4], int c0) {
    float v[16];
#pragma unroll
    for (int j = 0; j < 4; ++j) { v[4 * j] = bflo(r.h[j].x); v[4 * j + 1] = bfhi(r.h[j].x); v[4 * j + 2] = bflo(r.h[j].y); v[4 * j + 3] = bfhi(r.h[j].y); }
#pragma unroll
    for (int k = 0; k <= TOPK; ++k) {
#pragma unroll
        for (int j = 0; j < 4; ++j) { const unsigned yy = (k < TOPK) ? r.y[k < TOPK ? k : 0][j] : r.ys[j];
            const f32x2 lo = __builtin_amdgcn_cvt_pk_f32_fp8((int)yy, false), hi = __builtin_amdgcn_cvt_pk_f32_fp8((int)yy, true);
            v[4 * j] += lo.x * (1.f / YSCALE); v[4 * j + 1] += lo.y * (1.f / YSCALE); v[4 * j + 2] += hi.x * (1.f / YSCALE); v[4 * j + 3] += hi.y * (1.f / YSCALE); }
        asm volatile("" : "+v"(v[0]), "+v"(v[1]), "+v"(v[2]), "+v"(v[3]), "+v"(v[4]), "+v"(v[5]), "+v"(v[6]), "+v"(v[7]), "+v"(v[8]), "+v"(v[9]), "+v"(v[10]), "+v"(v[11]), "+v"(v[12]), "+v"(v[13]), "+v"(v[14]), "+v"(v[15]));
    }
    float ss = 0.f;
#pragma unroll
    for (int j = 0; j < 16; ++j) ss += v[j] * v[j];
    const float rs = rsqf_(wave_sum(ss) * (1.f / D) + EPS);
    float* o = out + (size_t)tok * D + c0;
#pragma unroll
    for (int j = 0; j < 4; ++j) { const f32x4 g = gv[j];
        OUT_STORE(((f32x4){v[4 * j] * rs * g.x, v[4 * j + 1] * rs * g.y, v[4 * j + 2] * rs * g.z, v[4 * j + 3] * rs * g.w}), (f32x4*)(o + 256 * j)); }
}
__device__ __forceinline__ void combine_phase(Frame& F, const MoeTab& T) {
    const bf16* H1 = (const bf16*)(F.ws + WS_H1); const unsigned char* YR = F.ws + WS_YR; const unsigned char* YS = F.ws + WS_YS; const int* slot = (const int*)(F.ws + WS_SLOT); const float* gf = F.in[18];
    const int gw = F.vcu * NWAVES + F.wave, NGW = F.G * NWAVES, lane = F.lane, c0 = 4 * lane;
    if (gw >= NTOK) return;
    CRows ra, rb;
    f32x4 gv[4];
#pragma unroll
    for (int j = 0; j < 4; ++j) gv[j] = *(const f32x4*)(gf + c0 + 256 * j);
    int tok = gw;
    int sl = slot[(size_t)tok * 8 + (lane & 7)];
    int sln = (tok + NGW < NTOK) ? slot[(size_t)(tok + NGW) * 8 + (lane & 7)] : 0;
    comb_issue(ra, tok, sl, H1, YR, YS, T, c0);
    for (;;) {
        const int t1 = tok + NGW, t2 = tok + 2 * NGW, t3 = tok + 3 * NGW;
        int sl2 = (t2 < NTOK) ? slot[(size_t)t2 * 8 + (lane & 7)] : 0;
        if (t1 < NTOK) comb_issue(rb, t1, sln, H1, YR, YS, T, c0);
        if (t1 < NTOK && t2 < NTOK) __builtin_amdgcn_s_waitcnt(0x8F79); else __builtin_amdgcn_s_waitcnt(0x0F70);
        __builtin_amdgcn_sched_barrier(0);
        comb_finish(ra, tok, F.out, gv, c0);
        __builtin_amdgcn_sched_barrier(0);
        if (t1 >= NTOK) break;
        sln = (t3 < NTOK) ? slot[(size_t)t3 * 8 + (lane & 7)] : 0;
        if (t2 < NTOK) comb_issue(ra, t2, sl2, H1, YR, YS, T, c0);
        if (t2 < NTOK && t3 < NTOK) __builtin_amdgcn_s_waitcnt(0x8F79); else __builtin_amdgcn_s_waitcnt(0x0F70);
        __builtin_amdgcn_sched_barrier(0);
        comb_finish(rb, t1, F.out, gv, c0);
        __builtin_amdgcn_sched_barrier(0);
        if (t2 >= NTOK) break;
        tok = t2;
    }
}

__global__ void __launch_bounds__(NTHREADS, 2) mega_fwd(Args args) {
    extern __shared__ __attribute__((aligned(16))) unsigned char lds[];
    Frame F;
    F.lds = (LAS unsigned char*)lds;
    F.tid = threadIdx.x; F.lane = F.tid & 63; F.wave = __builtin_amdgcn_readfirstlane(F.tid >> 6);
    F.G = gridDim.x; { const int bx = blockIdx.x; F.vcu = (F.G % 8 == 0) ? (bx % 8) * (F.G / 8) + bx / 8 : bx; }
#pragma unroll
    for (int i = 0; i < 19; ++i) F.in[i] = args.in[i];
    F.out = args.out; F.ws = args.ws;
    volatile LAS unsigned* MISC = (volatile LAS unsigned*)(F.lds + MISC_OFF);
    for (int u = F.tid; u < 32; u += NTHREADS) MISC[u] = 0u;
    __syncthreads();
    unsigned* ctl = (unsigned*)(F.ws + WS_CTL);
    XcdBarrier bar = xcd_barrier_post(ctl + CW_BAR, MISC + 8);
    const int lo = args.ph_lo, hi = args.ph_hi;
#define IN(k) (lo <= (k) && (k) < hi)
#define BOTH(k) (IN(k) && IN((k) + 1))

    if (IN(0)) { REP(0) p0_prologue(F); if (BOTH(0)) xcd_barrier(bar); }
    if (IN(1)) {
        constexpr int GEMM_CUS = GEMM_CUS_CFG;
        if ((int)blockIdx.x < GEMM_CUS || F.G <= GEMM_CUS) {
            ProbIn p{(const bf16*)(F.ws + WS_XN), (const bf16*)(F.ws + WS_WIN), (bf16*)(F.ws + WS_PROJ)};
            const int ge = F.G > GEMM_CUS ? GEMM_CUS : F.G;
#if FAST_GEMM & 1
            REP(1) fg::gemm_phase(F, p, ge);
#else
            simple_gemm_phase(F, p, ge);
#endif
        }
        if (F.G <= GEMM_CUS) { meta_proj(F, F.vcu * NWAVES + F.wave, F.G * NWAVES); if (GEMM_CUS_CFG < 256) p0_convert(F, P0_NONEXPERT + P0_SPLIT, P0_NITEMS, F.vcu * NWAVES + F.wave, F.G * NWAVES); }
        else if ((int)blockIdx.x >= GEMM_CUS) { const int gw = ((int)blockIdx.x - GEMM_CUS) * NWAVES + F.wave, ngw = (F.G - GEMM_CUS) * NWAVES; meta_proj(F, gw, ngw); p0_convert(F, P0_NONEXPERT + P0_SPLIT, P0_NITEMS, gw, ngw); }
        if (BOTH(1)) xcd_barrier(bar); }
#if FAST_HGRN
    if (IN(2)) {
#if HGRN_SEG
        hg::pass_a2(F); xcd_barrier(bar); hg::scan_seg(F); xcd_barrier(bar); hg::pass_c2(F);
#else
        REP(2) hg::pass_a(F); xcd_barrier(bar); REP(3) hg::scan_phase(F); xcd_barrier(bar); REP(4) hg::pass_c(F);
#endif
        if (BOTH(2)) xcd_barrier(bar); }
#else
    if (IN(2)) { hgrn_naive(F); if (BOTH(2)) xcd_barrier(bar); }
#endif
#if !FAST_HGRN
    if (IN(3)) { REP(5) post_phase(F); if (BOTH(3)) xcd_barrier(bar); }
#endif
    if (IN(4)) { ProbOut p{(const bf16*)(F.ws + WS_Y), (const bf16*)(F.ws + WS_WOUT), F.in[0], (bf16*)(F.ws + WS_H1), (float*)(F.ws + WS_SUMSQ), ProbE1::FP8 ? F.ws + WS_H1Q : nullptr, (const bf16*)(F.ws + WS_XN), (const float*)(F.ws + WS_RINV)};
#if FAST_GEMM & 2
        fg::gemm_phase(F, p);
#else
        simple_gemm_out(F, p);
#endif
        if (BOTH(4)) xcd_barrier(bar); }
    if (IN(5)) { router_phase(F); if (BOTH(5)) xcd_barrier(bar); }
    MoeTab T; T.cnt = nullptr; T.rowbase = nullptr; T.tb = nullptr;
    if (IN(6) || IN(7) || IN(8)) moe_build_tab(F, T);
    if (IN(6)) { ProbE1 p{T, ProbE1::FP8 ? (const bf16*)(F.ws + WS_H1Q) : (const bf16*)(F.ws + WS_H1), (const bf16*)((unsigned char*)F.out + OUT_WGU), (const int*)(F.ws + WS_TOK), (const f32x2*)(F.ws + WS_SCL), (const f32x2*)(F.ws + WS_SCLS), (bf16*)(F.ws + WS_HID), (LAS int*)(F.lds + IDX_OFF)};
#if FAST_GEMM & 4
        moe_fill_units(F, p, (LAS int*)(F.lds + UT_OFF)); e1_fill_idx(F, p); REP(6) fg::gemm_phase(F, p);
#else
        simple_gemm_phase(F, p);
#endif
        if (BOTH(6)) xcd_barrier(bar); }
    if (IN(7)) { ProbE2 p{T, (const bf16*)(F.ws + WS_HID), (const bf16*)((unsigned char*)F.out + OUT_WD), F.ws + WS_YS, F.ws + WS_YR, 0, 0};
#if (FAST_GEMM & 8) && E2_CUSTOM
        static_assert(ProbE2Q, "the dedicated down-GEMM body is fp8 only");
        p.ntl = 128; fg::gemm_phase(F, p);
        e2::phase(F, T, (const unsigned char*)(F.ws + WS_HID), (const unsigned char*)F.out + OUT_WD, F.ws + WS_YR, F.ws + WS_DD);
#elif FAST_GEMM & 8
        moe_fill_units(F, p, (LAS int*)(F.lds + UT_OFF)); fg::gemm_phase(F, p);
        if ((REPEAT >> 7) & 1) { p.t0 = 128; fg::gemm_phase(F, p); }
#else
        simple_gemm_phase(F, p);
#endif
        if (BOTH(7)) xcd_barrier(bar); }
    if (IN(8)) { REP(8) combine_phase(F, T); for (int _r = 0; _r < ((REPEAT >> 9) & 1) * 8; ++_r) xcd_barrier(bar); }
#undef IN
#undef BOTH
}

extern "C" void kernel_launch(void* const* d_in, const int* in_sizes, int n_in, void* d_out, int out_size, void* d_ws, size_t ws_size, hipStream_t stream) {
    static int grid = 0;
    if (grid == 0) {
        if (n_in != 19 || in_sizes[0] != NTOK * D || out_size != NTOK * D || ws_size < WS_END) { fprintf(stderr, "kernel_launch: unexpected shapes / workspace (n_in %d, in0 %d, out %d, ws %zu)\n", n_in, n_in > 0 ? in_sizes[0] : -1, out_size, ws_size); grid = -1; return; }
        int dev = 0, cus = 0, per_cu = 0;
        if (hipGetDevice(&dev) != hipSuccess || hipDeviceGetAttribute(&cus, hipDeviceAttributeMultiprocessorCount, dev) != hipSuccess) { grid = -1; return; }
        if (hipFuncSetAttribute((const void*)mega_fwd, hipFuncAttributeMaxDynamicSharedMemorySize, LDS_BYTES) != hipSuccess) { fprintf(stderr, "kernel_launch: hipFuncSetAttribute failed\n"); grid = -1; return; }
        if (hipOccupancyMaxActiveBlocksPerMultiprocessor(&per_cu, (const void*)mega_fwd, NTHREADS, LDS_BYTES) != hipSuccess || per_cu < 1) { fprintf(stderr, "kernel_launch: occupancy query reports %d workgroups per CU\n", per_cu); grid = -1; return; }
        if (cus < 256) { fprintf(stderr, "kernel_launch: built for a 256-CU device (per-CU unit tables are sized for a 256-workgroup grid); found %d CUs\n", cus); grid = -1; return; }
        grid = 256;
    }
    if (grid < 0) return;
    (void)hipMemsetAsync((char*)d_ws + WS_CTL, 0, CTL_ZERO_BYTES, stream);
    Args a{};
    for (int i = 0; i < 19; ++i) a.in[i] = (const float*)d_in[i];
    a.out = (float*)d_out; a.ws = (unsigned char*)d_ws; a.ph_lo = 0; a.ph_hi = 9;
    void* kargs[] = {&a};
    const hipError_t e = hipLaunchCooperativeKernel((const void*)mega_fwd, dim3(grid), dim3(NTHREADS), kargs, LDS_BYTES, stream);
    if (e != hipSuccess) fprintf(stderr, "kernel_launch: cooperative launch failed: %s (grid %d)\n", hipGetErrorString(e), grid);
}
```
